# Optimizing an MI355X kernel written in HIP

```python
import jax, jax.numpy as jnp
from jax import lax
import numpy as np

D_MODEL = 1024
BATCH = 1
SEQ = 16384
DEPTH = 1

HEAD_DIM = 64
N_Q_HEADS = 8
N_KV_HEADS = 2
GROUP = N_Q_HEADS // N_KV_HEADS
WINDOW = 128
BLOCK = 128
ATTN_WIDTH = N_Q_HEADS * HEAD_DIM
KV_WIDTH = N_KV_HEADS * HEAD_DIM
CONV_WIDTH_CH = 512
CONV_TAPS = 3
MIX_WIDTH = ATTN_WIDTH + CONV_WIDTH_CH
IN_WIDTH = ATTN_WIDTH + 2 * KV_WIDTH + 3 * CONV_WIDTH_CH
D_FF = 2816
EPS = 1e-6
NEG_INF = -1e30

kernel_name = "hybrid_swa_sink_shortconv_convffn"


def rms_norm(x, w):
    xf = x.astype(jnp.float32)
    y = xf * lax.rsqrt(jnp.mean(xf * xf, axis=-1, keepdims=True) + EPS)
    return (y * w.astype(jnp.float32)).astype(x.dtype)


def causal_dwconv3(x, w):
    s = x.shape[1]
    xp = jnp.pad(x, ((0, 0), (CONV_TAPS - 1, 0), (0, 0)))
    y = xp[:, 0:s] * w[0]
    for i in range(1, CONV_TAPS):
        y = y + xp[:, i:i + s] * w[i]
    return y


def sliding_window_attention(q, k, v, sinks):
    bsz, s = q.shape[0], q.shape[1]
    nb = s // BLOCK
    qb = q.reshape(bsz, nb, BLOCK, N_KV_HEADS, GROUP, HEAD_DIM)
    pad = ((0, 0), (BLOCK, 0), (0, 0), (0, 0))
    kp = jnp.pad(k, pad).reshape(bsz, nb + 1, BLOCK, N_KV_HEADS, HEAD_DIM)
    vp = jnp.pad(v, pad).reshape(bsz, nb + 1, BLOCK, N_KV_HEADS, HEAD_DIM)
    kw = jnp.concatenate([kp[:, :-1], kp[:, 1:]], axis=2)
    vw = jnp.concatenate([vp[:, :-1], vp[:, 1:]], axis=2)
    scale = HEAD_DIM ** -0.5
    sc = jnp.einsum('bnqkgd,bnskd->bnkgqs', qb, kw).astype(jnp.float32) * scale
    qi = jnp.arange(BLOCK)[:, None]
    sj = jnp.arange(2 * BLOCK)[None, :]
    rel = qi + BLOCK - sj
    band = (rel >= 0) & (rel < WINDOW)
    kpos = jnp.arange(nb)[:, None] * BLOCK - BLOCK + jnp.arange(2 * BLOCK)[None, :]
    mask = band[None, :, :] & (kpos >= 0)[:, None, :]
    sc = jnp.where(mask[None, :, None, None, :, :], sc, jnp.float32(NEG_INF))
    sink = sinks.astype(jnp.float32).reshape(N_KV_HEADS, GROUP)[None, None, :, :, None, None]
    m = jnp.maximum(jnp.max(sc, axis=-1, keepdims=True), sink)
    p = jnp.exp(sc - m)
    denom = jnp.sum(p, axis=-1, keepdims=True) + jnp.exp(sink - m)
    p = (p / denom).astype(v.dtype)
    o = jnp.einsum('bnkgqs,bnskd->bnqkgd', p, vw)
    return o.reshape(bsz, s, ATTN_WIDTH)


def setup_inputs(seed: int = 0) -> dict:
    key = jax.random.key(seed)
    ks = jax.random.split(key, 16)
    f = jnp.float32
    L = DEPTH
    def gain(k, n):
        return jnp.ones((L, n), f) + 0.05 * jax.random.normal(k, (L, n), f)
    return {
        "x": jax.random.normal(ks[0], (BATCH, SEQ, D_MODEL), f),
        "attn_norm_w": gain(ks[1], D_MODEL),
        "w_in": jax.random.normal(ks[2], (L, D_MODEL, IN_WIDTH), f) * D_MODEL ** -0.5,
        "q_norm_w": gain(ks[3], HEAD_DIM),
        "k_norm_w": gain(ks[4], HEAD_DIM),
        "sinks": 0.5 * jax.random.normal(ks[5], (L, N_Q_HEADS), f),
        "conv_mix_w": jax.random.normal(ks[6], (L, CONV_TAPS, CONV_WIDTH_CH), f) * CONV_TAPS ** -0.5,
        "attn_out_norm_w": gain(ks[7], ATTN_WIDTH),
        "conv_out_norm_w": gain(ks[8], CONV_WIDTH_CH),
        "w_out": jax.random.normal(ks[9], (L, MIX_WIDTH, D_MODEL), f) * MIX_WIDTH ** -0.5,
        "ffn_norm_w": gain(ks[10], D_MODEL),
        "w_up": jax.random.normal(ks[11], (L, D_MODEL, 2 * D_FF), f) * D_MODEL ** -0.5,
        "ffn_conv_w": jax.random.normal(ks[12], (L, CONV_TAPS, 2 * D_FF), f) * CONV_TAPS ** -0.5,
        "w_down": jax.random.normal(ks[13], (L, D_FF, D_MODEL), f) * D_FF ** -0.5,
    }


def reference(x, attn_norm_w, w_in, q_norm_w, k_norm_w, sinks, conv_mix_w,
              attn_out_norm_w, conv_out_norm_w, w_out, ffn_norm_w, w_up,
              ffn_conv_w, w_down):
    bsz, s = x.shape[0], x.shape[1]
    splits = [ATTN_WIDTH,
              ATTN_WIDTH + KV_WIDTH,
              ATTN_WIDTH + 2 * KV_WIDTH,
              ATTN_WIDTH + 2 * KV_WIDTH + CONV_WIDTH_CH,
              ATTN_WIDTH + 2 * KV_WIDTH + 2 * CONV_WIDTH_CH]
    for l in range(DEPTH):
        h = rms_norm(x, attn_norm_w[l])
        proj = jnp.einsum('bsd,de->bse', h, w_in[l])
        q, k, v, bg, cg, u = jnp.split(proj, splits, axis=-1)
        q = rms_norm(q.reshape(bsz, s, N_Q_HEADS, HEAD_DIM), q_norm_w[l])
        k = rms_norm(k.reshape(bsz, s, N_KV_HEADS, HEAD_DIM), k_norm_w[l])
        v = v.reshape(bsz, s, N_KV_HEADS, HEAD_DIM)
        attn = sliding_window_attention(q, k, v, sinks[l])
        conv = bg * causal_dwconv3(cg * u, conv_mix_w[l])
        mix = jnp.concatenate([rms_norm(attn, attn_out_norm_w[l]),
                               rms_norm(conv, conv_out_norm_w[l])], axis=-1)
        x = x + jnp.einsum('bse,ed->bsd', mix, w_out[l])
        h = rms_norm(x, ffn_norm_w[l])
        up = causal_dwconv3(jnp.einsum('bsd,df->bsf', h, w_up[l]), ffn_conv_w[l])
        g, uu = jnp.split(up, [D_FF], axis=-1)
        x = x + jnp.einsum('bsf,fd->bsd', jax.nn.silu(g) * uu, w_down[l])
    return x
```

```cpp
#include <hip/hip_runtime.h>
#include <hip/hip_cooperative_groups.h>
#include <cstdio>
#include <cstdint>
namespace cg = cooperative_groups;

#define LAS __attribute__((address_space(3)))
typedef unsigned short bf16_t;
typedef short bf16x8 __attribute__((ext_vector_type(8)));
typedef float f32x4 __attribute__((ext_vector_type(4)));
typedef unsigned u32x4 __attribute__((ext_vector_type(4)));
typedef unsigned u32x2 __attribute__((ext_vector_type(2)));
typedef short s16x4 __attribute__((ext_vector_type(4)));

constexpr int SEQ = 16384, DM = 1024, NIN = 2304, DFF = 2816, NUP = 2 * DFF;
constexpr float EPS = 1e-6f;
constexpr float LOG2E = 1.4426950408889634f;
constexpr int COL_K = 512, COL_V = 640, COL_B = 768, COL_C = 1280, COL_U = 1792;
constexpr int PW = 1792, COL_CU = 1280;

constexpr size_t MiB = 1u << 20;
constexpr size_t WS_CTL = 0, CTL_ZERO_BYTES = 65536;
constexpr size_t WS_WIN = 1 * MiB;
constexpr size_t WS_WOUT = 6 * MiB;
constexpr size_t WS_WUP = 8 * MiB;
constexpr size_t WS_WDN = 20 * MiB;
constexpr size_t WS_PART = 26 * MiB;
constexpr size_t WS_EDGE = 170 * MiB;
constexpr size_t WS_XN = 34 * MiB;
constexpr size_t WS_PROJ = 66 * MiB;
constexpr size_t WS_MIX = 138 * MiB;
constexpr size_t WS_ACT = 66 * MiB;
constexpr size_t WS_END = 182 * MiB;

constexpr int RING_BYTES = 131072;
constexpr int XCH_OFF = RING_BYTES;
constexpr int CWS_OFF = 8192 + 256;
constexpr int RS_OFF = 8192 + 256 + 2 * 3072;
constexpr int MISC_OFF = XCH_OFF + 8192;
constexpr int LDS_BYTES = 147456;

typedef float f32x2_t __attribute__((ext_vector_type(2))); typedef __bf16 bf16x2_t __attribute__((ext_vector_type(2)));
__device__ __forceinline__ unsigned cvtpk(float lo, float hi) { f32x2_t v = {lo, hi}; bf16x2_t b = __builtin_convertvector(v, bf16x2_t); return __builtin_bit_cast(unsigned, b); }
__device__ __forceinline__ float bflo(unsigned u) { return __builtin_bit_cast(float, u << 16); }
__device__ __forceinline__ float bfhi(unsigned u) { return __builtin_bit_cast(float, u & 0xffff0000u); }
__device__ __forceinline__ float fast_rsqrt(float x) { return __builtin_amdgcn_rsqf(x); }
__device__ __forceinline__ float siluf(float g) { return g * __builtin_amdgcn_rcpf(1.0f + __builtin_amdgcn_exp2f(-g * LOG2E)); }

namespace pg8 {
constexpr int BM = 256, BK = 64, HALF = 128, HTB = HALF * BK * 2, STAGE_BYTES = 8 * HTB, NXCD = 8, WGM = 8;
__host__ __device__ __forceinline__ int lds_byte(int r, int c) { const int st = (r >> 4) * 2 + (c >> 5), rr = r & 15, cc = c & 31, ob = rr * 64 + cc * 2; return st * 1024 + (ob ^ (((ob >> 9) & 1) << 5)); }
__host__ __device__ __forceinline__ void stage_rc(int b, int& R, int& C) { const int st = b / 1024, sb = b % 1024, swz = sb ^ (((sb >> 9) & 1) << 5); R = (st >> 1) * 16 + swz / 64; C = (st & 1) * 32 + (swz % 64) / 2; }
__host__ __device__ __forceinline__ int perm32(int rho) { const int n = rho >> 4, i = rho & 15; return 8 * (i >> 2) + 4 * n + (i & 3); }

struct Unit { int pm, pn, h; };
struct Gemm { const bf16_t* A; const bf16_t* Bt; int M, N, K; };

struct StaticOrder {
    int nM, nN, nwg, G, c;
    __host__ __device__ void init(int M, int N, int G_, int c_) { nM = M / BM; nN = N / BM; nwg = nM * nN; G = G_; c = c_; }
    __host__ __device__ bool next(int i, Unit& u) const {
        const long L = (long)i * G + c; if (L >= nwg) return false;
        int wgid = (int)L; { const int q = nwg / NXCD, r = nwg % NXCD, xcd = wgid % NXCD, off = wgid / NXCD; wgid = (xcd < r ? xcd * (q + 1) : r * (q + 1) + (xcd - r) * q) + off; }
        const int nig = WGM * nN, gid = wgid / nig, fm = gid * WGM, gsz = (nM - fm) < WGM ? (nM - fm) : WGM;
        u.pm = fm + ((wgid % nig) % gsz); u.pn = (wgid % nig) / gsz; u.h = -1; return true;
    }
    __host__ __device__ int index_of(int pm, int pn) const {
        if (nwg % NXCD != 0) return -1;
        const int nig = WGM * nN, gid = pm / WGM, fm = gid * WGM, gsz = (nM - fm) < WGM ? (nM - fm) : WGM;
        const int wgid = gid * nig + pn * gsz + (pm - fm), q = nwg / NXCD;
        return (wgid % q) * NXCD + wgid / q;
    }
};
struct TailSplitOrder {
    StaticOrder b; int full, rem;
    __host__ __device__ void init(int M, int N, int G_, int c_) { b.init(M, N, G_, c_); full = b.nwg / G_; rem = b.nwg % G_; }
    __host__ __device__ bool team_form() const { return b.nwg % NXCD == 0 && b.nM == NXCD * WGM && b.G == 256 && rem != 0 && 2 * rem <= b.G && (full * (b.G / NXCD)) % WGM == 0; }
    __host__ __device__ bool next(int i, Unit& u) const {
        if (i < full || 2 * rem > b.G) return b.next(i, u);
        if (i > full) return false;
        if (team_form()) {
            const int x = b.c % NXCD, a = b.c / NXCD, p = a % WGM, s = a / WGM, q = b.nwg / NXCD, w0 = full * (b.G / NXCD), ntp = (q - w0) / WGM;
            if (s >= 2 * ntp) return false;
            const int w = w0 + WGM * (s >> 1) + p;
            u.pm = x * WGM + p; u.pn = w / WGM; u.h = s & 1; return true;
        }
        if (b.c >= 2 * rem) return false;
        StaticOrder t = b; t.c = b.c >> 1; if (!t.next(full, u)) return false;
        u.h = b.c & 1; return true;
    }
    __host__ __device__ int tail_busy() const {
        if (rem == 0) return 0;
        if (2 * rem > b.G) return rem;
        return 2 * rem;
    }
};

template <bool ROWPERM = false, bool HT = false, class Epi, class Sched>
__device__ __forceinline__ void gemm_phase(LAS unsigned char* lds, const Gemm g, const Sched& S, const Epi& E) {
    int tid_l = threadIdx.x; asm volatile("" : "+v"(tid_l));
    const int tid = tid_l, wid = __builtin_amdgcn_readfirstlane(tid >> 6), lane = tid & 63, wr = wid >> 2, wc = wid & 3, fr = lane & 15, fq = lane >> 4;
    const int K = g.K, nt = K / BK;
    unsigned voffA[2], voffB[2];
#pragma unroll
    for (int i = 0; i < 2; ++i) { int R, C; stage_rc(tid * 16 + i * 8192, R, C); const int Rb = (R & ~31) + perm32(R & 31);
        const int Ra = ROWPERM ? ((R & 64) | ((R & 15) << 2) | ((R >> 4) & 3)) : R;
        voffA[i] = (unsigned)(Ra * K + C) * 2u; voffB[i] = (unsigned)(Rb * K + C) * 2u; }
    const size_t kstep = (size_t)(BK * 2);
    const size_t hstep = (size_t)HALF * K * 2;
    const size_t tstep = 2 * hstep;
    const unsigned ldsw = (unsigned)wid * 1024u;
    const int aoff = lds_byte(wr * 64 + fr, fq * 8), boff = lds_byte(wc * 32 + fr, fq * 8);
#define PG8_SA(b, h) (((b) * 2 + (h)) * HTB)
#define PG8_SB(b, h) ((4 + (b) * 2 + (h)) * HTB)
#define PG8_STAGE(bufoff, gbase, voff) do { _Pragma("unroll") for (int _i = 0; _i < 2; ++_i) \
        __builtin_amdgcn_global_load_lds((const unsigned*)((const char*)(gbase) + (voff)[_i]), (LAS unsigned*)(lds + (bufoff) + ldsw + _i * 8192), 16, 0, 0); } while (0)
#define PG8_LDA(dst, b, h) do { _Pragma("unroll") for (int m = 0; m < 4; ++m) _Pragma("unroll") for (int k = 0; k < 2; ++k) dst[m][k] = *(const LAS bf16x8*)(lds + PG8_SA(b, h) + aoff + m * 2048 + k * 1024); } while (0)
#define PG8_LDB(dst, b, h) do { _Pragma("unroll") for (int n = 0; n < 2; ++n) _Pragma("unroll") for (int k = 0; k < 2; ++k) dst[n][k] = *(const LAS bf16x8*)(lds + PG8_SB(b, h) + boff + n * 2048 + k * 1024); } while (0)
#define PG8_MMA(ai, bj, At, Bt) do { __builtin_amdgcn_s_setprio(1); _Pragma("unroll") for (int m = 0; m < 4; ++m) _Pragma("unroll") for (int n = 0; n < 2; ++n) _Pragma("unroll") for (int k = 0; k < 2; ++k) \
        acc[ai][bj][m][n] = __builtin_amdgcn_mfma_f32_16x16x32_bf16(Bt[n][k], At[m][k], acc[ai][bj][m][n], 0, 0, 0); __builtin_amdgcn_s_setprio(0); } while (0)
#define PG8_WAIT_V(n) asm volatile("s_waitcnt vmcnt(" #n ")" ::: "memory")
#define PG8_WAIT_L(n) asm volatile("s_waitcnt lgkmcnt(" #n ")" ::: "memory")
#define PG8_BAR __builtin_amdgcn_s_barrier()
#define PG8_SCHED __builtin_amdgcn_sched_barrier(0)
    Unit cur, nxt; int ui = 0;
    if (!S.next(0, cur)) return;
    f32x4 acc[2][2][4][2];
#pragma unroll
    for (int a = 0; a < 2; ++a)
#pragma unroll
        for (int b = 0; b < 2; ++b)
#pragma unroll
            for (int m = 0; m < 4; ++m)
#pragma unroll
                for (int n = 0; n < 2; ++n) acc[a][b][m][n] = (f32x4){0.f, 0.f, 0.f, 0.f};
    bf16x8 At[4][2], B0[2][2], B1[2][2];
    const char* cA = (const char*)g.A + (size_t)cur.pm * tstep + ((HT && cur.h > 0) ? hstep : 0); const char* cB = (const char*)g.Bt + (size_t)cur.pn * tstep;
    size_t hsA = (HT && cur.h >= 0) ? 0 : hstep;
    PG8_STAGE(PG8_SB(0, 0), cB, voffB); PG8_STAGE(PG8_SB(0, 1), cB + hstep, voffB); PG8_STAGE(PG8_SA(0, 0), cA, voffA); PG8_STAGE(PG8_SA(0, 1), cA + hsA, voffA);
    if (wr == 1) PG8_BAR;
    PG8_WAIT_V(2); PG8_BAR;
    PG8_STAGE(PG8_SB(1, 0), cB + kstep, voffB); PG8_STAGE(PG8_SA(1, 0), cA + kstep, voffA); PG8_STAGE(PG8_SB(1, 1), cB + hstep + kstep, voffB);
    PG8_WAIT_V(6); PG8_BAR;
    for (;;) {
        const bool has_next = S.next(ui + 1, nxt);
        const char* nA = has_next ? (const char*)g.A + (size_t)nxt.pm * tstep + ((HT && nxt.h > 0) ? hstep : 0) : cA; const char* nB = has_next ? (const char*)g.Bt + (size_t)nxt.pn * tstep : cB;
        const size_t nhsA = has_next ? ((HT && nxt.h >= 0) ? (size_t)0 : hstep) : hsA;
        const bool full_u = !(HT && cur.h >= 0);
        for (int t = 0; t < nt; t += 2) {
            const bool last = (t == nt - 2);
            const char* a1 = cA + (size_t)(t + 1) * kstep;
            const char* a2 = last ? nA : cA + (size_t)(t + 2) * kstep; const char* b2 = last ? nB : cB + (size_t)(t + 2) * kstep;
            const char* a3 = a2 + kstep; const char* b3 = b2 + kstep;
            const size_t hs2 = last ? nhsA : hsA;
            PG8_LDB(B0, 0, 0); PG8_LDB(B1, 0, 1); PG8_SCHED; PG8_LDA(At, 0, 0); PG8_STAGE(PG8_SA(1, 1), a1 + hsA, voffA);
            PG8_WAIT_V(8); PG8_WAIT_L(0); PG8_BAR; PG8_MMA(0, 0, At, B0); PG8_MMA(0, 1, At, B1); PG8_BAR; PG8_SCHED;
            if (full_u) PG8_LDA(At, 0, 1); PG8_STAGE(PG8_SB(0, 0), b2, voffB); PG8_STAGE(PG8_SB(0, 1), b2 + hstep, voffB); PG8_STAGE(PG8_SA(0, 0), a2, voffA);
            PG8_WAIT_V(8); PG8_WAIT_L(0); PG8_BAR; if (full_u) { PG8_MMA(1, 0, At, B0); PG8_MMA(1, 1, At, B1); } PG8_BAR; PG8_SCHED;
            PG8_LDB(B0, 1, 0); PG8_LDB(B1, 1, 1); PG8_SCHED; PG8_LDA(At, 1, 0); PG8_STAGE(PG8_SA(0, 1), a2 + hs2, voffA);
            PG8_WAIT_V(8); PG8_WAIT_L(0); PG8_BAR; PG8_MMA(0, 0, At, B0); PG8_MMA(0, 1, At, B1); PG8_BAR; PG8_SCHED;
            if (full_u) PG8_LDA(At, 1, 1); PG8_STAGE(PG8_SB(1, 0), b3, voffB); PG8_STAGE(PG8_SB(1, 1), b3 + hstep, voffB); PG8_STAGE(PG8_SA(1, 0), a3, voffA);
            PG8_WAIT_V(8); PG8_WAIT_L(0); PG8_BAR; if (full_u) { PG8_MMA(1, 0, At, B0); PG8_MMA(1, 1, At, B1); } PG8_BAR; PG8_SCHED;
        }
        if (wr == 0) PG8_BAR;
        E(acc, cur, wr, wc, fr, fq, nxt, has_next, ui);
        if (!has_next) break;
#pragma unroll
        for (int a = 0; a < 2; ++a)
#pragma unroll
            for (int b = 0; b < 2; ++b)
#pragma unroll
                for (int m = 0; m < 4; ++m)
#pragma unroll
                    for (int n = 0; n < 2; ++n) acc[a][b][m][n] = (f32x4){0.f, 0.f, 0.f, 0.f};
        cur = nxt; cA = nA; cB = nB; hsA = nhsA; ++ui;
        if (wr == 1) PG8_BAR;
    }
    PG8_WAIT_V(0);
    PG8_BAR;
#undef PG8_SA
#undef PG8_SB
#undef PG8_STAGE
#undef PG8_LDA
#undef PG8_LDB
#undef PG8_MMA
#undef PG8_WAIT_V
#undef PG8_WAIT_L
#undef PG8_BAR
#undef PG8_SCHED
}
}

struct EpiInProj {
    bf16_t* P; const float* qw; const float* kw; float qscale;
    __device__ __forceinline__ void operator()(const f32x4 (&acc)[2][2][4][2], const pg8::Unit& u, int wr, int wc, int fr_in, int fq_in, const pg8::Unit&, bool, int) const {
        int fr = fr_in, fq = fq_in; asm volatile("" : "+v"(fr), "+v"(fq));
        const int nai = u.h < 0 ? 2 : 1, rowh = u.pm * 256 + (u.h > 0 ? 128 : 0);
        const int tile = u.pn;
        const bool isq = tile < 2, isk = (tile == 2) && (wc < 2);
        const bool nrm = isq || isk;
        f32x4 gw[2][2];
#pragma unroll
        for (int bj = 0; bj < 2; ++bj)
#pragma unroll
            for (int n = 0; n < 2; ++n) {
                const int d = 32 * bj + 8 * fq + 4 * n;
                f32x4 w = (f32x4){1.f, 1.f, 1.f, 1.f};
                if (isq) w = *(const f32x4*)(qw + d) * qscale; else if (isk) w = *(const f32x4*)(kw + d);
                gw[bj][n] = w;
            }
        if (tile >= 5) {
            const int colc = COL_CU + 128 * (tile - 5) + 32 * wc + 8 * fq;
#pragma unroll
            for (int ai = 0; ai < 2; ++ai)
#pragma unroll
                for (int m = 0; m < 4; ++m) {
                    if (ai >= nai) continue;
                    const int row = rowh + ai * 128 + wr * 64 + m * 16 + fr;
                    const f32x4 a = acc[ai][0][m][0] * acc[ai][1][m][0], b = acc[ai][0][m][1] * acc[ai][1][m][1];
                    u32x4 w; w.x = cvtpk(a[0], a[1]); w.y = cvtpk(a[2], a[3]); w.z = cvtpk(b[0], b[1]); w.w = cvtpk(b[2], b[3]);
                    *(u32x4*)(P + (size_t)row * PW + colc) = w;
                }
            return;
        }
        const int colb = 256 * tile + 64 * wc + 8 * fq;
#pragma unroll
        for (int ai = 0; ai < 2; ++ai)
#pragma unroll
            for (int m = 0; m < 4; ++m) {
                if (ai >= nai) continue;
                    const int row = rowh + ai * 128 + wr * 64 + m * 16 + fr;
                f32x4 v[2][2];
#pragma unroll
                for (int bj = 0; bj < 2; ++bj)
#pragma unroll
                    for (int n = 0; n < 2; ++n) v[bj][n] = acc[ai][bj][m][n];
                if (nrm) {
                    float ss = 0.f;
#pragma unroll
                    for (int bj = 0; bj < 2; ++bj)
#pragma unroll
                        for (int n = 0; n < 2; ++n) { const f32x4 x = v[bj][n]; ss += (x[0] * x[0] + x[1] * x[1]) + (x[2] * x[2] + x[3] * x[3]); }
                    ss += __shfl_xor(ss, 16); ss += __shfl_xor(ss, 32);
                    const float r = fast_rsqrt(ss * (1.0f / 64.0f) + EPS);
#pragma unroll
                    for (int bj = 0; bj < 2; ++bj)
#pragma unroll
                        for (int n = 0; n < 2; ++n) v[bj][n] = v[bj][n] * r * gw[bj][n];
                }
                bf16_t* rowp = P + (size_t)row * PW + colb;
#pragma unroll
                for (int bj = 0; bj < 2; ++bj) {
                    u32x4 w; w.x = cvtpk(v[bj][0][0], v[bj][0][1]); w.y = cvtpk(v[bj][0][2], v[bj][0][3]); w.z = cvtpk(v[bj][1][0], v[bj][1][1]); w.w = cvtpk(v[bj][1][2], v[bj][1][3]);
                    *(u32x4*)(rowp + 32 * bj) = w;
                }
            }
    }
};

struct EpiOutProj {
    const float* x; bf16_t* xn; float* part;
    __device__ __forceinline__ void operator()(const f32x4 (&acc)[2][2][4][2], const pg8::Unit& u, int wr, int wc, int fr_in, int fq_in, const pg8::Unit&, bool, int) const {
        int fr = fr_in, fq = fq_in; asm volatile("" : "+v"(fr), "+v"(fq));
        const int col0 = u.pn * 256 + wc * 32 + 8 * fq;
#pragma unroll
        for (int ai = 0; ai < 2; ++ai)
#pragma unroll
            for (int m = 0; m < 4; ++m) {
                const int row = u.pm * 256 + ai * 128 + wr * 64 + m * 16 + fr;
                const size_t off = (size_t)row * DM + col0;
                float ss = 0.f;
#pragma unroll
                for (int bj = 0; bj < 2; ++bj) {
                    const f32x4 x0 = *(const f32x4*)(x + off + bj * 128), x1 = *(const f32x4*)(x + off + bj * 128 + 4);
                    const f32x4 a = x0 + acc[ai][bj][m][0], b = x1 + acc[ai][bj][m][1];
                    ss += (a[0] * a[0] + a[1] * a[1]) + (a[2] * a[2] + a[3] * a[3]) + (b[0] * b[0] + b[1] * b[1]) + (b[2] * b[2] + b[3] * b[3]);
                    u32x4 w; w.x = cvtpk(a[0], a[1]); w.y = cvtpk(a[2], a[3]); w.z = cvtpk(b[0], b[1]); w.w = cvtpk(b[2], b[3]);
                    *(u32x4*)(xn + off + bj * 128) = w;
                }
                ss += __shfl_xor(ss, 16); ss += __shfl_xor(ss, 32);
                if (fq == 0) part[(size_t)row * 16 + u.pn * 4 + wc] = ss;
            }
    }
};

struct EpiDown {
    const bf16_t* xn; float* out;
    __device__ __forceinline__ void operator()(const f32x4 (&acc)[2][2][4][2], const pg8::Unit& u, int wr, int wc, int fr_in, int fq_in, const pg8::Unit&, bool, int) const {
        int fr = fr_in, fq = fq_in; asm volatile("" : "+v"(fr), "+v"(fq));
        const int col0 = u.pn * 256 + wc * 32 + 8 * fq;
#pragma unroll
        for (int ai = 0; ai < 2; ++ai)
#pragma unroll
            for (int m = 0; m < 4; ++m) {
                const int row = u.pm * 256 + ai * 128 + wr * 64 + m * 16 + fr;
                const size_t off = (size_t)row * DM + col0;
#pragma unroll
                for (int bj = 0; bj < 2; ++bj) {
                    const u32x4 r = *(const u32x4*)(xn + off + bj * 128);
                    const f32x4 x0 = (f32x4){bflo(r.x), bfhi(r.x), bflo(r.y), bfhi(r.y)}, x1 = (f32x4){bflo(r.z), bfhi(r.z), bflo(r.w), bfhi(r.w)};
                    *(f32x4*)(out + off + bj * 128) = x0 + acc[ai][bj][m][0]; *(f32x4*)(out + off + bj * 128 + 4) = x1 + acc[ai][bj][m][1];
                }
            }
    }
};

__device__ __forceinline__ float dpp_shr1(float old, float src) { return __builtin_bit_cast(float, __builtin_amdgcn_update_dpp(__builtin_bit_cast(int, old), __builtin_bit_cast(int, src), 0x111, 0xf, 0xf, false)); }

struct EpiUpConv {
    bf16_t* act; const float* part; const float* cw; float* edge; LAS unsigned char* xch; mutable int rs_pm;
    __device__ __forceinline__ void operator()(f32x4 (&acc)[2][2][4][2], const pg8::Unit& u, int wr, int wc, int fr_in, int fq_in, const pg8::Unit& nxt, bool has_next, int ui) const {
        int fr = fr_in, fq = fq_in, tid = threadIdx.x;
        asm volatile("" : "+v"(fr), "+v"(fq), "+v"(tid));
        LAS f32x4* H = (LAS f32x4*)xch;
        LAS f32x4* CW = (LAS f32x4*)(xch + CWS_OFF) + (ui & 1) * 192;
        LAS f32x4* CWN = (LAS f32x4*)(xch + CWS_OFF) + ((ui + 1) & 1) * 192;
        LAS float* RS = (LAS float*)(xch + RS_OFF);
        const int nai = u.h < 0 ? 2 : 1, rbase = u.h > 0 ? 128 : 0;
        const int ctap = tid >> 6, cr = tid & 63;
        f32x4 cwv = (f32x4){0.f, 0.f, 0.f, 0.f}, cwn = (f32x4){0.f, 0.f, 0.f, 0.f};
        if (ui == 0 && tid < 192) cwv = *(const f32x4*)(cw + (size_t)ctap * NUP + (cr >> 5) * DFF + 128 * u.pn + 4 * (cr & 31));
        if (has_next && tid < 192) cwn = *(const f32x4*)(cw + (size_t)ctap * NUP + (cr >> 5) * DFF + 128 * nxt.pn + 4 * (cr & 31));
        if (u.pm != rs_pm) {
            if (tid < 256) {
                const float* pp = part + (size_t)(u.pm * 256 + tid) * 16;
                const f32x4 p0 = *(const f32x4*)pp, p1 = *(const f32x4*)(pp + 4), p2 = *(const f32x4*)(pp + 8), p3 = *(const f32x4*)(pp + 12);
                const float s = ((p0[0] + p0[1]) + (p0[2] + p0[3])) + ((p1[0] + p1[1]) + (p1[2] + p1[3])) + ((p2[0] + p2[1]) + (p2[2] + p2[3])) + ((p3[0] + p3[1]) + (p3[2] + p3[3]));
                RS[tid] = fast_rsqrt(s * (1.0f / (float)DM) + EPS);
            }
            asm volatile("s_waitcnt lgkmcnt(0)" ::: "memory"); __builtin_amdgcn_s_barrier(); asm volatile("" ::: "memory");
            rs_pm = u.pm;
        }
#pragma unroll
        for (int ai = 0; ai < 2; ++ai)
#pragma unroll
            for (int m = 0; m < 4; ++m) {
                if (ai >= nai) continue;
                const float rs = RS[rbase + ai * 128 + wr * 64 + 4 * fr + m];
#pragma unroll
                for (int bj = 0; bj < 2; ++bj)
#pragma unroll
                    for (int n = 0; n < 2; ++n) acc[ai][bj][m][n] = acc[ai][bj][m][n] * rs;
            }
        if (ui == 0 && tid < 192) CW[tid] = cwv;
        if (fr == 15) {
#pragma unroll
            for (int ai = 0; ai < 2; ++ai)
#pragma unroll
                for (int bj = 0; bj < 2; ++bj)
#pragma unroll
                    for (int n = 0; n < 2; ++n) {
                        H[((((ai * 2 + wr) * 4 + wc) * 2 + 0) * 4 + (bj * 2 + n)) * 4 + fq] = acc[ai][bj][2][n];
                        H[((((ai * 2 + wr) * 4 + wc) * 2 + 1) * 4 + (bj * 2 + n)) * 4 + fq] = acc[ai][bj][3][n];
                    }
        }
        const int colg = 128 * u.pn + 32 * wc + 8 * fq;
        if (wr == 0 && fr == 0) {
#pragma unroll
            for (int rsel = 0; rsel < 2; ++rsel) {
                float* e = edge + ((size_t)(u.pm * 8 + (u.h > 0 ? 6 : 0) + rsel)) * NUP + colg;
#pragma unroll
                for (int bj = 0; bj < 2; ++bj)
#pragma unroll
                    for (int n = 0; n < 2; ++n) *(f32x4*)(e + bj * DFF + 4 * n) = acc[0][bj][rsel][n];
            }
        }
        if (wr == 1 && fr == 15) {
#pragma unroll
            for (int rsel = 0; rsel < 2; ++rsel) {
                float* e = edge + ((size_t)(u.pm * 8 + (u.h == 0 ? 4 : 2) + rsel)) * NUP + colg;
#pragma unroll
                for (int bj = 0; bj < 2; ++bj)
#pragma unroll
                    for (int n = 0; n < 2; ++n) *(f32x4*)(e + bj * DFF + 4 * n) = (nai == 2) ? acc[1][bj][2 + rsel][n] : acc[0][bj][2 + rsel][n];
            }
        }
        asm volatile("s_waitcnt lgkmcnt(0)" ::: "memory"); __builtin_amdgcn_s_barrier(); asm volatile("" ::: "memory");
        const int cwi = 8 * wc + 2 * fq;
#pragma unroll
        for (int ai = 0; ai < 2; ++ai) {
            if (ai >= nai) continue;
            const int chunk = ai * 2 + wr;
            const int pch = chunk > 0 ? chunk - 1 : 0;
            u32x2 res[4][2];
#pragma unroll
            for (int n = 0; n < 2; ++n) {
                f32x4 y[2][4];
#pragma unroll
                for (int bj = 0; bj < 2; ++bj) {
                    const f32x4 w0 = CW[cwi + 32 * bj + n], w1 = CW[64 + cwi + 32 * bj + n], w2 = CW[128 + cwi + 32 * bj + n];
                    const f32x4 h62 = H[(((pch * 4 + wc) * 2 + 0) * 4 + (bj * 2 + n)) * 4 + fq], h63 = H[(((pch * 4 + wc) * 2 + 1) * 4 + (bj * 2 + n)) * 4 + fq];
                    const f32x4 x0 = acc[ai][bj][0][n], x1 = acc[ai][bj][1][n], x2 = acc[ai][bj][2][n], x3 = acc[ai][bj][3][n];
                    f32x4 p2, p3;
#pragma unroll
                    for (int j = 0; j < 4; ++j) { p2[j] = dpp_shr1(h62[j], x2[j]); p3[j] = dpp_shr1(h63[j], x3[j]); }
                    y[bj][0] = w2 * x0 + w1 * p3 + w0 * p2;
                    y[bj][1] = w2 * x1 + w1 * x0 + w0 * p3;
                    y[bj][2] = w2 * x2 + w1 * x1 + w0 * x0;
                    y[bj][3] = w2 * x3 + w1 * x2 + w0 * x1;
                }
#pragma unroll
                for (int m = 0; m < 4; ++m) {
                    const f32x4 g = y[0][m], v = y[1][m];
                    res[m][n].x = cvtpk(siluf(g[0]) * v[0], siluf(g[1]) * v[1]); res[m][n].y = cvtpk(siluf(g[2]) * v[2], siluf(g[3]) * v[3]);
                }
            }
#pragma unroll
            for (int m = 0; m < 4; ++m) {
                const int rt = ai * 128 + wr * 64 + 4 * fr + m;
                if (rt >= 2) { u32x4 w; w.x = res[m][0].x; w.y = res[m][0].y; w.z = res[m][1].x; w.w = res[m][1].y;
                    *(u32x4*)(act + (size_t)(u.pm * 256 + rbase + rt) * DFF + colg) = w; }
            }
        }
        if (has_next && tid < 192) CWN[tid] = cwn;
    }
};

__device__ __forceinline__ float wave_sum(float v) {
#pragma unroll
    for (int o = 1; o < 64; o <<= 1) v += __shfl_xor(v, o);
    return v;
}
template <int MODE>
__device__ __forceinline__ void p0_transpose_item(const float* W, int K, int N, bf16_t* WT, const float* gain, LAS float* scr, int item, int lane) {
    const int nblk = N / 32, kb = item / nblk, nb = item % nblk, k0 = 64 * kb, n0 = 32 * nb;
    int p0;
    if (MODE == 0) p0 = n0;
    else if (MODE == 1) {
        if (n0 < COL_C) { const int tile = n0 >> 8, c = n0 & 255, wc = c >> 6, bj = (c >> 5) & 1; p0 = tile * 256 + 128 * bj + 32 * wc; }
        else if (n0 < COL_U) { const int cc = n0 - COL_C; p0 = (5 + (cc >> 7)) * 256 + (cc & 127); }
        else { const int uc = n0 - COL_U; p0 = (5 + (uc >> 7)) * 256 + 128 + (uc & 127); }
    }
    else { if (n0 < DFF) p0 = 256 * (n0 >> 7) + (n0 & 127); else { const int n1 = n0 - DFF; p0 = 256 * (n1 >> 7) + 128 + (n1 & 127); } }
#pragma unroll 8
    for (int i = 0; i < 32; ++i) { const int kk = 2 * i + (lane >> 5); float v = W[(size_t)(k0 + kk) * N + n0 + (lane & 31)]; if (MODE == 2) v *= gain[k0 + kk]; scr[kk * 33 + (lane & 31)] = v; }
    asm volatile("s_waitcnt lgkmcnt(0)" ::: "memory");
    const int c = lane & 7;
#pragma unroll
    for (int j = 0; j < 4; ++j) { const int n = (lane >> 3) + 8 * j; const LAS float* s = scr + (8 * c) * 33 + n;
        u32x4 o; o.x = cvtpk(s[0 * 33], s[1 * 33]); o.y = cvtpk(s[2 * 33], s[3 * 33]); o.z = cvtpk(s[4 * 33], s[5 * 33]); o.w = cvtpk(s[6 * 33], s[7 * 33]);
        *(u32x4*)(WT + (size_t)(p0 + n) * K + k0 + 8 * c) = o; }
    asm volatile("s_waitcnt lgkmcnt(0)" ::: "memory");
}

namespace p2 {
constexpr int KPITCH = 72;
constexpr int KS_BYTES = 2 * 192 * KPITCH * 2;
constexpr int VT_OFF = KS_BYTES, VT_BYTES = 2 * 208 * KPITCH * 2;
constexpr int SS_OFF = VT_OFF + VT_BYTES;
static_assert(SS_OFF + 2048 <= RING_BYTES, "P2 LDS");
static_assert(XCH_OFF + RS_OFF + 1024 <= LDS_BYTES && MISC_OFF + 128 <= XCH_OFF + CWS_OFF, "exchange LDS map");
}

struct Args { const float* in[14]; float* out; unsigned char* ws; int cg_flag; int pad; };

__device__ __forceinline__ void p2_unit(LAS unsigned char* lds, const bf16_t* __restrict__ proj, bf16_t* __restrict__ mix, const float* __restrict__ sinks, const float* __restrict__ aw,
                                        const float* __restrict__ cmw, const float* __restrict__ cow, int unit, int tid, int lane, int wave) {
    using namespace p2;
    asm volatile("" : "+v"(tid), "+v"(lane));
    const int q0 = unit * 64;
    u32x4 kreg[6], vreg[6];
#pragma unroll
    for (int i = 0; i < 6; ++i) {
        const int id = i * 512 + tid, c = id & 7, rest = id >> 3, kv = rest / 192, kidx = rest - kv * 192, tok = q0 - 128 + kidx;
        kreg[i] = (u32x4){0u, 0u, 0u, 0u}; vreg[i] = (u32x4){0u, 0u, 0u, 0u};
        if (tok >= 0) { const bf16_t* src = proj + (size_t)tok * PW; kreg[i] = *(const u32x4*)(src + COL_K + 64 * kv + 8 * c); vreg[i] = *(const u32x4*)(src + COL_V + 64 * kv + 8 * c); }
    }
    __builtin_amdgcn_sched_barrier(0);
    const int c0 = 8 * lane, t0 = q0 + 8 * wave;
    u32x4 Cv[10], Bv[8];
#define P2_LOAD_CU(i) do { const int t_ = t0 - 2 + (i); Cv[i] = (u32x4){0u, 0u, 0u, 0u}; \
        if (t_ >= 0) Cv[i] = *(const u32x4*)(proj + (size_t)t_ * PW + c0 + COL_CU); } while (0)
#define P2_LOAD_B(i) do { Bv[i] = *(const u32x4*)(proj + (size_t)(t0 + (i)) * PW + c0 + COL_B); } while (0)
    P2_LOAD_CU(0); P2_LOAD_CU(1); P2_LOAD_CU(2); P2_LOAD_CU(3); P2_LOAD_CU(4); P2_LOAD_CU(5);
    P2_LOAD_B(0); P2_LOAD_B(1); P2_LOAD_B(2); P2_LOAD_B(3);
    float w0[8], w1[8], w2[8], gn[8];
#pragma unroll
    for (int hf = 0; hf < 2; ++hf) {
        const f32x4 a = *(const f32x4*)(cmw + c0 + 4 * hf), b = *(const f32x4*)(cmw + 512 + c0 + 4 * hf), c = *(const f32x4*)(cmw + 1024 + c0 + 4 * hf), d = *(const f32x4*)(cow + c0 + 4 * hf);
#pragma unroll
        for (int e = 0; e < 4; ++e) { w0[4 * hf + e] = a[e]; w1[4 * hf + e] = b[e]; w2[4 * hf + e] = c[e]; gn[4 * hf + e] = d[e]; }
    }
    __builtin_amdgcn_sched_barrier(0);
#pragma unroll
    for (int i = 0; i < 6; ++i) {
        const int id = i * 512 + tid, c = id & 7, rest = id >> 3, kv = rest / 192, kidx = rest - kv * 192;
        *(LAS u32x4*)(lds + ((kv * 192 + kidx) * KPITCH + 8 * c) * 2) = kreg[i];
        *(LAS u32x4*)(lds + VT_OFF + ((kv * 208 + kidx) * KPITCH + 8 * c) * 2) = vreg[i];
    }
    if (tid < 256) { const int kv = tid >> 7, r = (tid >> 3) & 15, c = tid & 7; *(LAS u32x4*)(lds + VT_OFF + ((kv * 208 + 192 + r) * KPITCH + 8 * c) * 2) = (u32x4){0u, 0u, 0u, 0u}; }
    __builtin_amdgcn_sched_barrier(0);
    P2_LOAD_CU(6); P2_LOAD_CU(7); P2_LOAD_CU(8); P2_LOAD_CU(9);
    P2_LOAD_B(4); P2_LOAD_B(5); P2_LOAD_B(6); P2_LOAD_B(7);
    __builtin_amdgcn_sched_barrier(0);
    float cm2[8], cm1[8];
#define P2_CONV_STEP(i) do { const u32x4 C = Cv[i]; float cu[8]; \
        cu[0] = bflo(C.x); cu[1] = bfhi(C.x); cu[2] = bflo(C.y); cu[3] = bfhi(C.y); cu[4] = bflo(C.z); cu[5] = bfhi(C.z); cu[6] = bflo(C.w); cu[7] = bfhi(C.w); \
        if ((i) >= 2) { const u32x4 B = Bv[(i) >= 2 ? (i) - 2 : 0]; \
            const float bb[8] = {bflo(B.x), bfhi(B.x), bflo(B.y), bfhi(B.y), bflo(B.z), bfhi(B.z), bflo(B.w), bfhi(B.w)}; \
            float cv[8]; float ss = 0.f; \
            _Pragma("unroll") for (int e = 0; e < 8; ++e) { const float y = w0[e] * cm2[e] + w1[e] * cm1[e] + w2[e] * cu[e]; cv[e] = bb[e] * y; ss += cv[e] * cv[e]; } \
            ss = wave_sum(ss); \
            const float r = fast_rsqrt(ss * (1.0f / 512.0f) + EPS); \
            u32x4 w; w.x = cvtpk(cv[0] * r * gn[0], cv[1] * r * gn[1]); w.y = cvtpk(cv[2] * r * gn[2], cv[3] * r * gn[3]); \
            w.z = cvtpk(cv[4] * r * gn[4], cv[5] * r * gn[5]); w.w = cvtpk(cv[6] * r * gn[6], cv[7] * r * gn[7]); \
            *(u32x4*)(mix + (size_t)(t0 + (i) - 2) * DM + 512 + c0) = w; } \
        _Pragma("unroll") for (int e = 0; e < 8; ++e) { cm2[e] = ((i) == 0) ? 0.f : cm1[e]; cm1[e] = cu[e]; } } while (0)
    P2_CONV_STEP(0); P2_CONV_STEP(1); P2_CONV_STEP(2); P2_CONV_STEP(3); P2_CONV_STEP(4); P2_CONV_STEP(5);
    __builtin_amdgcn_sched_barrier(0);
    const int h = wave, kvh = h >> 2, fr = lane & 15, fq = lane >> 4;
    bf16x8 Qf[4][2];
#pragma unroll
    for (int qt = 0; qt < 4; ++qt) {
        const bf16_t* qp = proj + (size_t)(q0 + 16 * qt + fr) * PW + 64 * h + 8 * fq;
        Qf[qt][0] = *(const bf16x8*)qp; Qf[qt][1] = *(const bf16x8*)(qp + 32);
    }
    const float sink2 = sinks[h] * LOG2E;
    __builtin_amdgcn_sched_barrier(0);
    P2_CONV_STEP(6); P2_CONV_STEP(7); P2_CONV_STEP(8); P2_CONV_STEP(9);
#undef P2_LOAD_CU
#undef P2_LOAD_B
#undef P2_CONV_STEP
    __syncthreads();
    LAS float* SSf = (LAS float*)(lds + SS_OFF);
    const bool early = q0 < 128;
    f32x4 O[4][4];
#pragma unroll
    for (int qt = 0; qt < 4; ++qt) {
        const bf16x8 Q0 = Qf[qt][0], Q1 = Qf[qt][1];
        f32x4 S[9];
#pragma unroll
        for (int kt = 0; kt < 9; ++kt) {
            const LAS unsigned char* kp = lds + ((kvh * 192 + 16 * (qt + kt) + fr) * KPITCH + 8 * fq) * 2;
            const bf16x8 K0 = *(const LAS bf16x8*)kp, K1 = *(const LAS bf16x8*)(kp + 64);
            f32x4 a = (f32x4){0.f, 0.f, 0.f, 0.f};
            a = __builtin_amdgcn_mfma_f32_16x16x32_bf16(K0, Q0, a, 0, 0, 0);
            a = __builtin_amdgcn_mfma_f32_16x16x32_bf16(K1, Q1, a, 0, 0, 0);
            S[kt] = a;
        }
        float mx = sink2;
#pragma unroll
        for (int kt = 0; kt < 9; ++kt)
#pragma unroll
            for (int j = 0; j < 4; ++j) {
                const int jt = q0 - 128 + 16 * (qt + kt) + 4 * fq + j;
                bool valid = early ? (jt >= 0) : true;
                if (kt == 0) valid = valid && (fr < 4 * fq + j);
                if (kt == 8) valid = valid && (fr >= 4 * fq + j);
                const float sv = valid ? S[kt][j] : -1e30f;
                S[kt][j] = sv; mx = fmaxf(mx, sv);
            }
        mx = fmaxf(mx, __shfl_xor(mx, 16)); mx = fmaxf(mx, __shfl_xor(mx, 32));
        float l = 0.f;
#pragma unroll
        for (int kt = 0; kt < 9; ++kt)
#pragma unroll
            for (int j = 0; j < 4; ++j) { const float p = __builtin_amdgcn_exp2f(S[kt][j] - mx); S[kt][j] = p; l += p; }
        l += __shfl_xor(l, 16); l += __shfl_xor(l, 32);
        l += __builtin_amdgcn_exp2f(sink2 - mx);
        const float inv = __builtin_amdgcn_rcpf(l);
        bf16x8 pb[5];
#pragma unroll
        for (int s2 = 0; s2 < 5; ++s2) {
            u32x4 w; w.x = cvtpk(S[2 * s2][0], S[2 * s2][1]); w.y = cvtpk(S[2 * s2][2], S[2 * s2][3]);
            if (2 * s2 + 1 < 9) { w.z = cvtpk(S[2 * s2 + 1 < 9 ? 2 * s2 + 1 : 0][0], S[2 * s2 + 1 < 9 ? 2 * s2 + 1 : 0][1]); w.w = cvtpk(S[2 * s2 + 1 < 9 ? 2 * s2 + 1 : 0][2], S[2 * s2 + 1 < 9 ? 2 * s2 + 1 : 0][3]); }
            else { w.z = 0u; w.w = 0u; }
            pb[s2] = __builtin_bit_cast(bf16x8, w);
        }
#pragma unroll
        for (int dt = 0; dt < 4; ++dt) {
            f32x4 o = (f32x4){0.f, 0.f, 0.f, 0.f};
#pragma unroll
            for (int s2 = 0; s2 < 5; ++s2) {
                const LAS unsigned char* vp = lds + VT_OFF + ((kvh * 208 + 16 * (qt + 2 * s2) + 4 * fq + (fr >> 2)) * KPITCH + 16 * dt + 4 * (fr & 3)) * 2;
                const s16x4 lo = __builtin_amdgcn_ds_read_tr16_b64_v4i16((LAS s16x4*)vp), hi = __builtin_amdgcn_ds_read_tr16_b64_v4i16((LAS s16x4*)(vp + 16 * KPITCH * 2));
                const bf16x8 vfb = (bf16x8){lo[0], lo[1], lo[2], lo[3], hi[0], hi[1], hi[2], hi[3]};
                o = __builtin_amdgcn_mfma_f32_16x16x32_bf16(vfb, pb[s2], o, 0, 0, 0);
            }
            O[qt][dt] = o * inv;
        }
        float ss = 0.f;
#pragma unroll
        for (int dt = 0; dt < 4; ++dt) { const f32x4 o = O[qt][dt]; ss += (o[0] * o[0] + o[1] * o[1]) + (o[2] * o[2] + o[3] * o[3]); }
        ss += __shfl_xor(ss, 16); ss += __shfl_xor(ss, 32);
        if (fq == 0) SSf[h * 64 + 16 * qt + fr] = ss;
    }
    __syncthreads();
#pragma unroll
    for (int qt = 0; qt < 4; ++qt) {
        float tot = 0.f;
#pragma unroll
        for (int hh = 0; hh < 8; ++hh) tot += SSf[hh * 64 + 16 * qt + fr];
        const float r = fast_rsqrt(tot * (1.0f / 512.0f) + EPS);
        bf16_t* mp = mix + (size_t)(q0 + 16 * qt + fr) * DM + 64 * h + 4 * fq;
#pragma unroll
        for (int dt = 0; dt < 4; ++dt) {
            const f32x4 g = *(const f32x4*)(aw + 64 * h + 16 * dt + 4 * fq);
            const f32x4 v = O[qt][dt] * r * g;
            u32x2 w; w.x = cvtpk(v[0], v[1]); w.y = cvtpk(v[2], v[3]);
            *(u32x2*)(mp + 16 * dt) = w;
        }
    }
    __syncthreads();
}

#define XB_TMO      128
#define XB_XCNT(j)  (256  + 64 * (j))
#define XB_XSUB(j)  (1280 + 64 * (j))
#define XB_XGEN(j)  (2304 + 64 * (j))
#define XB_TOP      3328
#define XB_TOPGEN   3392
#define XCD_BAR_WORDS 3456
#define XB_SPIN_CAP (1u << 18)
__device__ __forceinline__ unsigned xb_ld(unsigned* p)              { return __hip_atomic_load(p, __ATOMIC_RELAXED, __HIP_MEMORY_SCOPE_AGENT); }
__device__ __forceinline__ unsigned xb_add(unsigned* p, unsigned v) { return __hip_atomic_fetch_add(p, v, __ATOMIC_RELAXED, __HIP_MEMORY_SCOPE_AGENT); }
__device__ __forceinline__ unsigned xb_xcc_id() { return (unsigned)__builtin_amdgcn_s_getreg((3 << 11) | 20) & 0xFu; }
#define XB_SPIN(cond, bar) do { unsigned _sp = 0; while (cond) { __builtin_amdgcn_s_sleep(1); \
    if ((++_sp & 255u) == 0u) { if (xb_ld(&(bar)[XB_TMO])) break; if (_sp > XB_SPIN_CAP) { atomicAdd(&(bar)[XB_TMO], 1u); break; } } } } while (0)
struct XcdBarrier { unsigned* bar; unsigned x; volatile LAS unsigned* st; };
__device__ __forceinline__ XcdBarrier xcd_barrier_post(unsigned* bar, volatile LAS unsigned* st) {
    XcdBarrier b; b.bar = bar; b.x = xb_xcc_id(); b.st = st;
    if (threadIdx.x == 0) (void)xb_add(&bar[XB_XCNT(b.x)], 1u);
    return b;
}
__device__ __forceinline__ void xcd_barrier_complete(unsigned* bar, unsigned x, unsigned& nloc, unsigned& nx) {
    const unsigned G = gridDim.x * gridDim.y * gridDim.z;
    unsigned sum, cnt, mine, sp = 0u;
    for (;;) {
        sum = 0u; cnt = 0u; mine = 0u;
#pragma unroll
        for (unsigned j = 0; j < 16; ++j) { const unsigned c = xb_ld(&bar[XB_XCNT(j)]); sum += c; cnt += (c > 0u) ? 1u : 0u; mine = (j == x) ? c : mine; }
        if (sum == G) break;
        __builtin_amdgcn_s_sleep(1);
        if ((++sp & 255u) == 0u) { if (xb_ld(&bar[XB_TMO])) break; if (sp > XB_SPIN_CAP) { atomicAdd(&bar[XB_TMO], 1u); break; } }
    }
    nloc = mine > 0u ? mine : 1u; nx = cnt > 0u ? cnt : 1u;
}
__device__ __forceinline__ void xcd_barrier(const XcdBarrier& b) {
    asm volatile("s_waitcnt vmcnt(0)" ::: "memory");
    __syncthreads();
    if (threadIdx.x == 0) {
        unsigned* bar = b.bar;
        __builtin_amdgcn_s_waitcnt(0);
        unsigned nloc = b.st[0], nx = b.st[1];
        if (nloc == 0u) { xcd_barrier_complete(bar, b.x, nloc, nx); b.st[0] = nloc; b.st[1] = nx; }
        const unsigned old = xb_add(&bar[XB_XSUB(b.x)], 1u);
        const unsigned gen = old / nloc;
        if (old + 1u == (gen + 1u) * nloc) {
            __builtin_amdgcn_fence(__ATOMIC_RELEASE, "agent");
            asm volatile("s_waitcnt vmcnt(0)" ::: "memory");
            const unsigned og = xb_add(&bar[XB_TOP], 1u);
            const unsigned tg = og / nx;
            if (og + 1u == (tg + 1u) * nx) xb_add(&bar[XB_TOPGEN], 1u);
            else XB_SPIN(xb_ld(&bar[XB_TOPGEN]) == tg, bar);
            __builtin_amdgcn_fence(__ATOMIC_ACQUIRE, "agent");
            xb_add(&bar[XB_XGEN(b.x)], 1u);
            asm volatile("s_waitcnt vmcnt(0)" ::: "memory");
        } else {
            XB_SPIN(xb_ld(&bar[XB_XGEN(b.x)]) == gen, bar);
            __builtin_amdgcn_fence(__ATOMIC_ACQUIRE, "agent");
            asm volatile("s_waitcnt vmcnt(0)" ::: "memory");
        }
    }
    __syncthreads();
}

__device__ __forceinline__ void fix_rows(bf16_t* dst, const float* cw, const float* et, const float* e1, const float* e2, int f0) {
    float yv[2][8];
#pragma unroll
    for (int bj = 0; bj < 2; ++bj)
#pragma unroll
        for (int hf = 0; hf < 2; ++hf) {
            const int col = bj * DFF + f0 + 4 * hf;
            const f32x4 w0 = *(const f32x4*)(cw + col), w1 = *(const f32x4*)(cw + NUP + col), w2 = *(const f32x4*)(cw + 2 * NUP + col);
            const f32x4 z = (f32x4){0.f, 0.f, 0.f, 0.f};
            const f32x4 xt = *(const f32x4*)(et + col), x1 = e1 ? *(const f32x4*)(e1 + col) : z, x2 = e2 ? *(const f32x4*)(e2 + col) : z;
            const f32x4 y = w0 * x2 + w1 * x1 + w2 * xt;
#pragma unroll
            for (int e = 0; e < 4; ++e) yv[bj][4 * hf + e] = y[e];
        }
    u32x4 w; w.x = cvtpk(siluf(yv[0][0]) * yv[1][0], siluf(yv[0][1]) * yv[1][1]); w.y = cvtpk(siluf(yv[0][2]) * yv[1][2], siluf(yv[0][3]) * yv[1][3]);
    w.z = cvtpk(siluf(yv[0][4]) * yv[1][4], siluf(yv[0][5]) * yv[1][5]); w.w = cvtpk(siluf(yv[0][6]) * yv[1][6], siluf(yv[0][7]) * yv[1][7]);
    *(u32x4*)dst = w;
}

__device__ __forceinline__ void convert_w_in(const Args& a, bf16_t* Win_t, LAS float* scr, int gw, int NGW, int lane) {
    constexpr int I_IN = (DM / 64) * (NIN / 32);
    for (int it = gw; it < I_IN; it += NGW) p0_transpose_item<1>(a.in[2], DM, NIN, Win_t, nullptr, scr, it, lane);
}
__device__ __forceinline__ void convert_w_out_up(const Args& a, bf16_t* Wout_t, bf16_t* Wup_t, LAS float* scr, int gw, int NGW, int lane) {
    constexpr int I_OUT = (DM / 64) * (DM / 32), I_UP = (DM / 64) * (NUP / 32);
    for (int it = gw; it < I_OUT + I_UP; it += NGW) {
        if (it < I_OUT) p0_transpose_item<0>(a.in[9], DM, DM, Wout_t, nullptr, scr, it, lane);
        else p0_transpose_item<2>(a.in[11], DM, NUP, Wup_t, a.in[10], scr, it - I_OUT, lane);
    }
}
__device__ __forceinline__ void convert_w_down(const Args& a, bf16_t* Wdn_t, LAS float* scr, int gw, int NGW, int lane) {
    constexpr int I_DN = (DFF / 64) * (DM / 32);
    for (int it = gw; it < I_DN; it += NGW) p0_transpose_item<0>(a.in[13], DFF, DM, Wdn_t, nullptr, scr, it, lane);
}

__global__ void __launch_bounds__(512, 2) fwd_megakernel(Args a) {
    extern __shared__ __attribute__((aligned(16))) unsigned char lds_raw[];
    LAS unsigned char* lds = (LAS unsigned char*)lds_raw;
    cg::grid_group grid = cg::this_grid();
    const int tid = threadIdx.x, lane = tid & 63, wave = __builtin_amdgcn_readfirstlane(tid >> 6);
    const int G = gridDim.x, bx = blockIdx.x;
    unsigned char* ws = a.ws;
    volatile LAS unsigned* MISC = (volatile LAS unsigned*)(lds + MISC_OFF);
    if (tid < 32) MISC[tid] = 0u;
    __syncthreads();
    const XcdBarrier bar = xcd_barrier_post((unsigned*)(ws + WS_CTL), MISC + 8);
    if (a.cg_flag) grid.sync();
#define GRID_BAR() xcd_barrier(bar)
    const float* x = a.in[0]; float* out = a.out;
    bf16_t* Win_t = (bf16_t*)(ws + WS_WIN); bf16_t* Wout_t = (bf16_t*)(ws + WS_WOUT); bf16_t* Wup_t = (bf16_t*)(ws + WS_WUP); bf16_t* Wdn_t = (bf16_t*)(ws + WS_WDN);
    float* part = (float*)(ws + WS_PART); float* edge = (float*)(ws + WS_EDGE);
    bf16_t* XN = (bf16_t*)(ws + WS_XN); bf16_t* proj = (bf16_t*)(ws + WS_PROJ); bf16_t* mix = (bf16_t*)(ws + WS_MIX); bf16_t* act = (bf16_t*)(ws + WS_ACT);
    LAS float* scr = (LAS float*)(lds + wave * 16384);

    {
        const int gw = bx * 8 + wave, NGW = G * 8;
        convert_w_in(a, Win_t, scr, gw, NGW, lane);
        const float* gw1 = a.in[1];
        f32x4 gv[4];
#pragma unroll
        for (int j = 0; j < 4; ++j) gv[j] = *(const f32x4*)(gw1 + 4 * lane + 256 * j);
        for (int m = gw; m < SEQ; m += 4 * NGW) {
            f32x4 v[4][4];
#pragma unroll
            for (int rr = 0; rr < 4; ++rr) {
                const int mr = m + rr * NGW;
                const f32x4* xr = (const f32x4*)(x + (size_t)(mr < SEQ ? mr : m) * DM) + lane;
#pragma unroll
                for (int j = 0; j < 4; ++j) v[rr][j] = xr[64 * j];
            }
#pragma unroll
            for (int rr = 0; rr < 4; ++rr) {
                const int mr = m + rr * NGW;
                float s = 0.f;
#pragma unroll
                for (int j = 0; j < 4; ++j) s += (v[rr][j][0] * v[rr][j][0] + v[rr][j][1] * v[rr][j][1]) + (v[rr][j][2] * v[rr][j][2] + v[rr][j][3] * v[rr][j][3]);
                const float r = fast_rsqrt(wave_sum(s) * (1.0f / DM) + EPS);
                if (mr < SEQ) {
                    unsigned long long* o8 = (unsigned long long*)(XN + (size_t)mr * DM) + lane;
#pragma unroll
                    for (int j = 0; j < 4; ++j) { const f32x4 y = v[rr][j] * r * gv[j]; o8[64 * j] = (unsigned long long)cvtpk(y[0], y[1]) | ((unsigned long long)cvtpk(y[2], y[3]) << 32); }
                }
            }
        }
    }
    GRID_BAR();

    {
        pg8::Gemm g{XN, Win_t, SEQ, NIN, DM}; pg8::TailSplitOrder S; S.init(SEQ, NIN, G, bx);
        EpiInProj E{proj, a.in[3], a.in[4], 0.125f * LOG2E};
        pg8::gemm_phase<false, true>(lds, g, S, E);
        const int rem = (2 * S.rem > G) ? S.rem : 2 * S.rem;
        if (rem == 0) convert_w_out_up(a, Wout_t, Wup_t, scr, bx * 8 + wave, G * 8, lane);
        else if (bx >= rem) convert_w_out_up(a, Wout_t, Wup_t, scr, (bx - rem) * 8 + wave, (G - rem) * 8, lane);
        if (rem == 0) convert_w_down(a, Wdn_t, scr, bx * 8 + wave, G * 8, lane);
        else if (bx >= rem) convert_w_down(a, Wdn_t, scr, (bx - rem) * 8 + wave, (G - rem) * 8, lane);
    }
    GRID_BAR();

    {
        constexpr int NU = SEQ / 64, NPER = NU / 8;
        const bool xa = (G & 7) == 0;
        const int base = xa ? (bx & 7) * NPER : 0, j0 = xa ? (bx >> 3) : bx, js = xa ? (G >> 3) : G, jn = xa ? NPER : NU;
        for (int j = j0; j < jn; j += js) p2_unit(lds, proj, mix, a.in[5], a.in[7], a.in[6], a.in[8], base + j, tid, lane, wave);
    }
    GRID_BAR();

    {
        pg8::Gemm g{mix, Wout_t, SEQ, DM, DM}; pg8::StaticOrder S; S.init(SEQ, DM, G, bx);
        EpiOutProj E{x, XN, part};
        pg8::gemm_phase(lds, g, S, E);
    }
    GRID_BAR();

    {
        pg8::Gemm g{XN, Wup_t, SEQ, NUP, DM}; pg8::TailSplitOrder S; S.init(SEQ, NUP, G, bx);
        EpiUpConv E{act, part, a.in[12], edge, lds + XCH_OFF, -1};
        pg8::gemm_phase<true, true>(lds, g, S, E);
    }
    GRID_BAR();

    {
        pg8::Gemm g{act, Wdn_t, SEQ, DM, DFF}; pg8::StaticOrder S; S.init(SEQ, DM, G, bx);
        const float* cw = a.in[12];
        constexpr int NCG = DFF / 8;
        pg8::TailSplitOrder S4; S4.init(SEQ, NUP, G, bx);
        const bool split4 = S4.rem != 0 && 2 * S4.rem <= G;
        pg8::Unit fu;
        for (int i = 0; S.next(i, fu); ++i) {
            const int pm = fu.pm;
            for (int id = tid; id < 2 * NCG; id += 512) {
                const int rs = id / NCG, f0 = 8 * (id - rs * NCG);
                const float* et = edge + (size_t)(pm * 8 + rs) * NUP;
                const float* e1 = rs == 0 ? (pm > 0 ? edge + (size_t)((pm - 1) * 8 + 3) * NUP : nullptr) : edge + (size_t)(pm * 8 + 0) * NUP;
                const float* e2 = pm > 0 ? edge + (size_t)((pm - 1) * 8 + (rs == 0 ? 2 : 3)) * NUP : nullptr;
                fix_rows(act + (size_t)(pm * 256 + rs) * DFF + f0, cw, et, e1, e2, f0);
            }
            if (split4) {
                for (int pn4 = 0; pn4 < S4.b.nN; ++pn4) {
                    const int L = S4.b.index_of(pm, pn4);
                    if (L < S4.full * G) continue;
                    if (tid < 32) {
                        const int rs = tid >> 4, f0 = 128 * pn4 + 8 * (tid & 15);
                        const float* et = edge + (size_t)(pm * 8 + 6 + rs) * NUP;
                        const float* e1 = edge + (size_t)(pm * 8 + (rs == 0 ? 5 : 6)) * NUP;
                        const float* e2 = edge + (size_t)(pm * 8 + (rs == 0 ? 4 : 5)) * NUP;
                        fix_rows(act + (size_t)(pm * 256 + 128 + rs) * DFF + f0, cw, et, e1, e2, f0);
                    }
                }
            }
        }
        asm volatile("s_waitcnt vmcnt(0)" ::: "memory");
        __syncthreads();
        EpiDown E{XN, out};
        pg8::gemm_phase(lds, g, S, E);
    }
}

extern "C" void kernel_launch(void* const* d_in, const int* in_sizes, int n_in, void* d_out, int out_size, void* d_ws, size_t ws_size, hipStream_t stream) {
    static int grid_blocks = 0;
    if (grid_blocks == 0) {
        if (n_in != 14 || in_sizes[0] != SEQ * DM || out_size != SEQ * DM || ws_size < WS_END) { fprintf(stderr, "kernel_launch: unexpected shapes (n_in %d, ws %zu)\n", n_in, ws_size); grid_blocks = -1; return; }
        int dev = 0, cus = 0, per_cu = 0;
        hipGetDevice(&dev);
        hipDeviceGetAttribute(&cus, hipDeviceAttributeMultiprocessorCount, dev);
        if (hipFuncSetAttribute((const void*)fwd_megakernel, hipFuncAttributeMaxDynamicSharedMemorySize, LDS_BYTES) != hipSuccess) { fprintf(stderr, "kernel_launch: hipFuncSetAttribute failed\n"); grid_blocks = -1; return; }
        hipOccupancyMaxActiveBlocksPerMultiprocessor(&per_cu, (const void*)fwd_megakernel, 512, LDS_BYTES);
        if (per_cu < 1) per_cu = 1;
        grid_blocks = cus * 1;
        (void)per_cu; (void)hipGetLastError();
    }
    if (grid_blocks < 0) return;
    Args a{};
    for (int i = 0; i < 14; ++i) a.in[i] = (const float*)d_in[i];
    a.out = (float*)d_out; a.ws = (unsigned char*)d_ws;
    if (hipMemsetAsync((char*)d_ws + WS_CTL, 0, CTL_ZERO_BYTES, stream) != hipSuccess) { fprintf(stderr, "kernel_launch: memset failed\n"); return; }
    void* args[] = {&a};
    hipError_t e = hipLaunchCooperativeKernel((const void*)fwd_megakernel, dim3(grid_blocks), dim3(512), args, LDS_BYTES, stream);
    if (e != hipSuccess) fprintf(stderr, "cooperative launch failed: %s (grid %d)\n", hipGetErrorString(e), grid_blocks);
}
```

```cpp
#include <hip/hip_runtime.h>
#include <hip/hip_cooperative_groups.h>
#include <cstdio>
#include <cstdint>
namespace cg = cooperative_groups;

#define LAS __attribute__((address_space(3)))
typedef unsigned short bf16_t;
typedef short bf16x8 __attribute__((ext_vector_type(8)));
typedef float f32x4 __attribute__((ext_vector_type(4)));
typedef unsigned u32x4 __attribute__((ext_vector_type(4)));
typedef unsigned u32x2 __attribute__((ext_vector_type(2)));
typedef short s16x4 __attribute__((ext_vector_type(4)));

constexpr int SEQ = 16384, DM = 1024, NIN = 2304, DFF = 2816, NUP = 2 * DFF;
constexpr float EPS = 1e-6f;
constexpr float LOG2E = 1.4426950408889634f;
constexpr int COL_K = 512, COL_V = 640, COL_B = 768, COL_C = 1280, COL_U = 1792;
constexpr int PW = 1792, COL_CU = 1280;

constexpr size_t MiB = 1u << 20;
constexpr size_t WS_CTL = 0, CTL_ZERO_BYTES = 65536;
constexpr size_t WS_WIN = 1 * MiB;
constexpr size_t WS_WOUT = 6 * MiB;
constexpr size_t WS_WUP = 8 * MiB;
constexpr size_t WS_WDN = 20 * MiB;
constexpr size_t WS_PART = 26 * MiB;
constexpr size_t WS_EDGE = 170 * MiB;
constexpr size_t WS_XN = 34 * MiB;
constexpr size_t WS_PROJ = 66 * MiB;
constexpr size_t WS_MIX = 138 * MiB;
constexpr size_t WS_ACT = 66 * MiB;
constexpr size_t WS_END = 182 * MiB;

constexpr int RING_BYTES = 131072;
constexpr int XCH_OFF = RING_BYTES;
constexpr int CWS_OFF = 8192 + 256;
constexpr int RS_OFF = 8192 + 256 + 2 * 3072;
constexpr int MISC_OFF = XCH_OFF + 8192;
constexpr int LDS_BYTES = 147456;

typedef float f32x2_t __attribute__((ext_vector_type(2))); typedef __bf16 bf16x2_t __attribute__((ext_vector_type(2)));
__device__ __forceinline__ unsigned cvtpk(float lo, float hi) { f32x2_t v = {lo, hi}; bf16x2_t b = __builtin_convertvector(v, bf16x2_t); return __builtin_bit_cast(unsigned, b); }
__device__ __forceinline__ float bflo(unsigned u) { return __builtin_bit_cast(float, u << 16); }
__device__ __forceinline__ float bfhi(unsigned u) { return __builtin_bit_cast(float, u & 0xffff0000u); }
__device__ __forceinline__ float fast_rsqrt(float x) { return __builtin_amdgcn_rsqf(x); }
__device__ __forceinline__ float siluf(float g) { return g * __builtin_amdgcn_rcpf(1.0f + __builtin_amdgcn_exp2f(-g * LOG2E)); }

namespace pg8 {
constexpr int BM = 256, BK = 64, HALF = 128, HTB = HALF * BK * 2, STAGE_BYTES = 8 * HTB, NXCD = 8, WGM = 8;
__host__ __device__ __forceinline__ int lds_byte(int r, int c) { const int st = (r >> 4) * 2 + (c >> 5), rr = r & 15, cc = c & 31, ob = rr * 64 + cc * 2; return st * 1024 + (ob ^ (((ob >> 9) & 1) << 5)); }
__host__ __device__ __forceinline__ void stage_rc(int b, int& R, int& C) { const int st = b / 1024, sb = b % 1024, swz = sb ^ (((sb >> 9) & 1) << 5); R = (st >> 1) * 16 + swz / 64; C = (st & 1) * 32 + (swz % 64) / 2; }
__host__ __device__ __forceinline__ int perm32(int rho) { const int n = rho >> 4, i = rho & 15; return 8 * (i >> 2) + 4 * n + (i & 3); }

struct Unit { int pm, pn, h; };
struct Gemm { const bf16_t* A; const bf16_t* Bt; int M, N, K; };

struct StaticOrder {
    int nM, nN, nwg, G, c;
    __host__ __device__ void init(int M, int N, int G_, int c_) { nM = M / BM; nN = N / BM; nwg = nM * nN; G = G_; c = c_; }
    __host__ __device__ bool next(int i, Unit& u) const {
        const long L = (long)i * G + c; if (L >= nwg) return false;
        int wgid = (int)L; { const int q = nwg / NXCD, r = nwg % NXCD, xcd = wgid % NXCD, off = wgid / NXCD; wgid = (xcd < r ? xcd * (q + 1) : r * (q + 1) + (xcd - r) * q) + off; }
        const int nig = WGM * nN, gid = wgid / nig, fm = gid * WGM, gsz = (nM - fm) < WGM ? (nM - fm) : WGM;
        u.pm = fm + ((wgid % nig) % gsz); u.pn = (wgid % nig) / gsz; u.h = -1; return true;
    }
    __host__ __device__ int index_of(int pm, int pn) const {
        if (nwg % NXCD != 0) return -1;
        const int nig = WGM * nN, gid = pm / WGM, fm = gid * WGM, gsz = (nM - fm) < WGM ? (nM - fm) : WGM;
        const int wgid = gid * nig + pn * gsz + (pm - fm), q = nwg / NXCD;
        return (wgid % q) * NXCD + wgid / q;
    }
};
struct TailSplitOrder {
    StaticOrder b; int full, rem;
    __host__ __device__ void init(int M, int N, int G_, int c_) { b.init(M, N, G_, c_); full = b.nwg / G_; rem = b.nwg % G_; }
    __host__ __device__ bool team_form() const { return b.nwg % NXCD == 0 && b.nM == NXCD * WGM && b.G == 256 && rem != 0 && 2 * rem <= b.G && (full * (b.G / NXCD)) % WGM == 0; }
    __host__ __device__ bool next(int i, Unit& u) const {
        if (i < full || 2 * rem > b.G) return b.next(i, u);
        if (i > full) return false;
        if (team_form()) {
            const int x = b.c % NXCD, a = b.c / NXCD, p = a % WGM, s = a / WGM, q = b.nwg / NXCD, w0 = full * (b.G / NXCD), ntp = (q - w0) / WGM;
            if (s >= 2 * ntp) return false;
            const int w = w0 + WGM * (s >> 1) + p;
            u.pm = x * WGM + p; u.pn = w / WGM; u.h = s & 1; return true;
        }
        if (b.c >= 2 * rem) return false;
        StaticOrder t = b; t.c = b.c >> 1; if (!t.next(full, u)) return false;
        u.h = b.c & 1; return true;
    }
    __host__ __device__ int tail_busy() const {
        if (rem == 0) return 0;
        if (2 * rem > b.G) return rem;
        return 2 * rem;
    }
};

template <bool ROWPERM = false, bool HT = false, class Epi, class Sched>
__device__ __forceinline__ void gemm_phase(LAS unsigned char* lds, const Gemm g, const Sched& S, const Epi& E) {
    int tid_l = threadIdx.x; asm volatile("" : "+v"(tid_l));
    const int tid = tid_l, wid = __builtin_amdgcn_readfirstlane(tid >> 6), lane = tid & 63, wr = wid >> 2, wc = wid & 3, fr = lane & 15, fq = lane >> 4;
    const int K = g.K, nt = K / BK;
    unsigned voffA[2], voffB[2];
#pragma unroll
    for (int i = 0; i < 2; ++i) { int R, C; stage_rc(tid * 16 + i * 8192, R, C); const int Rb = (R & ~31) + perm32(R & 31);
        const int Ra = ROWPERM ? ((R & 64) | ((R & 15) << 2) | ((R >> 4) & 3)) : R;
        voffA[i] = (unsigned)(Ra * K + C) * 2u; voffB[i] = (unsigned)(Rb * K + C) * 2u; }
    const size_t kstep = (size_t)(BK * 2);
    const size_t hstep = (size_t)HALF * K * 2;
    const size_t tstep = 2 * hstep;
    const unsigned ldsw = (unsigned)wid * 1024u;
    const int aoff = lds_byte(wr * 64 + fr, fq * 8), boff = lds_byte(wc * 32 + fr, fq * 8);
#define PG8_SA(b, h) (((b) * 2 + (h)) * HTB)
#define PG8_SB(b, h) ((4 + (b) * 2 + (h)) * HTB)
#define PG8_STAGE(bufoff, gbase, voff) do { _Pragma("unroll") for (int _i = 0; _i < 2; ++_i) \
        __builtin_amdgcn_global_load_lds((const unsigned*)((const char*)(gbase) + (voff)[_i]), (LAS unsigned*)(lds + (bufoff) + ldsw + _i * 8192), 16, 0, 0); } while (0)
#define PG8_LDA(dst, b, h) do { _Pragma("unroll") for (int m = 0; m < 4; ++m) _Pragma("unroll") for (int k = 0; k < 2; ++k) dst[m][k] = *(const LAS bf16x8*)(lds + PG8_SA(b, h) + aoff + m * 2048 + k * 1024); } while (0)
#define PG8_LDB(dst, b, h) do { _Pragma("unroll") for (int n = 0; n < 2; ++n) _Pragma("unroll") for (int k = 0; k < 2; ++k) dst[n][k] = *(const LAS bf16x8*)(lds + PG8_SB(b, h) + boff + n * 2048 + k * 1024); } while (0)
#define PG8_MMA(ai, bj, At, Bt) do { __builtin_amdgcn_s_setprio(1); _Pragma("unroll") for (int m = 0; m < 4; ++m) _Pragma("unroll") for (int n = 0; n < 2; ++n) _Pragma("unroll") for (int k = 0; k < 2; ++k) \
        acc[ai][bj][m][n] = __builtin_amdgcn_mfma_f32_16x16x32_bf16(Bt[n][k], At[m][k], acc[ai][bj][m][n], 0, 0, 0); __builtin_amdgcn_s_setprio(0); } while (0)
#define PG8_WAIT_V(n) asm volatile("s_waitcnt vmcnt(" #n ")" ::: "memory")
#define PG8_WAIT_L(n) asm volatile("s_waitcnt lgkmcnt(" #n ")" ::: "memory")
#define PG8_BAR __builtin_amdgcn_s_barrier()
#define PG8_SCHED __builtin_amdgcn_sched_barrier(0)
    Unit cur, nxt; int ui = 0;
    if (!S.next(0, cur)) return;
    f32x4 acc[2][2][4][2];
#pragma unroll
    for (int a = 0; a < 2; ++a)
#pragma unroll
        for (int b = 0; b < 2; ++b)
#pragma unroll
            for (int m = 0; m < 4; ++m)
#pragma unroll
                for (int n = 0; n < 2; ++n) acc[a][b][m][n] = (f32x4){0.f, 0.f, 0.f, 0.f};
    bf16x8 At[4][2], B0[2][2], B1[2][2];
    const char* cA = (const char*)g.A + (size_t)cur.pm * tstep + ((HT && cur.h > 0) ? hstep : 0); const char* cB = (const char*)g.Bt + (size_t)cur.pn * tstep;
    size_t hsA = (HT && cur.h >= 0) ? 0 : hstep;
    PG8_STAGE(PG8_SB(0, 0), cB, voffB); PG8_STAGE(PG8_SB(0, 1), cB + hstep, voffB); PG8_STAGE(PG8_SA(0, 0), cA, voffA); PG8_STAGE(PG8_SA(0, 1), cA + hsA, voffA);
    if (wr == 1) PG8_BAR;
    PG8_WAIT_V(2); PG8_BAR;
    PG8_STAGE(PG8_SB(1, 0), cB + kstep, voffB); PG8_STAGE(PG8_SA(1, 0), cA + kstep, voffA); PG8_STAGE(PG8_SB(1, 1), cB + hstep + kstep, voffB);
    PG8_WAIT_V(6); PG8_BAR;
    for (;;) {
        const bool has_next = S.next(ui + 1, nxt);
        const char* nA = has_next ? (const char*)g.A + (size_t)nxt.pm * tstep + ((HT && nxt.h > 0) ? hstep : 0) : cA; const char* nB = has_next ? (const char*)g.Bt + (size_t)nxt.pn * tstep : cB;
        const size_t nhsA = has_next ? ((HT && nxt.h >= 0) ? (size_t)0 : hstep) : hsA;
        const bool full_u = !(HT && cur.h >= 0);
#define PG8_KLOOP(FULL) \
        for (int t = 0; t < nt; t += 2) { \
            const bool last = (t == nt - 2); \
            const char* a1 = cA + (size_t)(t + 1) * kstep; \
            const char* a2 = last ? nA : cA + (size_t)(t + 2) * kstep; const char* b2 = last ? nB : cB + (size_t)(t + 2) * kstep; \
            const char* a3 = a2 + kstep; const char* b3 = b2 + kstep; \
            const size_t hs2 = last ? nhsA : hsA; \
            PG8_LDB(B0, 0, 0); PG8_LDB(B1, 0, 1); PG8_SCHED; PG8_LDA(At, 0, 0); PG8_STAGE(PG8_SA(1, 1), a1 + hsA, voffA); \
            PG8_WAIT_V(8); PG8_WAIT_L(0); PG8_BAR; PG8_MMA(0, 0, At, B0); PG8_MMA(0, 1, At, B1); PG8_BAR; PG8_SCHED; \
            if (FULL) PG8_LDA(At, 0, 1); PG8_STAGE(PG8_SB(0, 0), b2, voffB); PG8_STAGE(PG8_SB(0, 1), b2 + hstep, voffB); PG8_STAGE(PG8_SA(0, 0), a2, voffA); \
            PG8_WAIT_V(8); PG8_WAIT_L(0); PG8_BAR; if (FULL) { PG8_MMA(1, 0, At, B0); PG8_MMA(1, 1, At, B1); } PG8_BAR; PG8_SCHED; \
            PG8_LDB(B0, 1, 0); PG8_LDB(B1, 1, 1); PG8_SCHED; PG8_LDA(At, 1, 0); PG8_STAGE(PG8_SA(0, 1), a2 + hs2, voffA); \
            PG8_WAIT_V(8); PG8_WAIT_L(0); PG8_BAR; PG8_MMA(0, 0, At, B0); PG8_MMA(0, 1, At, B1); PG8_BAR; PG8_SCHED; \
            if (FULL) PG8_LDA(At, 1, 1); PG8_STAGE(PG8_SB(1, 0), b3, voffB); PG8_STAGE(PG8_SB(1, 1), b3 + hstep, voffB); PG8_STAGE(PG8_SA(1, 0), a3, voffA); \
            PG8_WAIT_V(8); PG8_WAIT_L(0); PG8_BAR; if (FULL) { PG8_MMA(1, 0, At, B0); PG8_MMA(1, 1, At, B1); } PG8_BAR; PG8_SCHED; \
        }
        if (full_u) { PG8_KLOOP(true) } else { PG8_KLOOP(false) }
#undef PG8_KLOOP
        if (wr == 0) PG8_BAR;
        E(acc, cur, wr, wc, fr, fq, nxt, has_next, ui);
        if (!has_next) break;
#pragma unroll
        for (int a = 0; a < 2; ++a)
#pragma unroll
            for (int b = 0; b < 2; ++b)
#pragma unroll
                for (int m = 0; m < 4; ++m)
#pragma unroll
                    for (int n = 0; n < 2; ++n) acc[a][b][m][n] = (f32x4){0.f, 0.f, 0.f, 0.f};
        cur = nxt; cA = nA; cB = nB; hsA = nhsA; ++ui;
        if (wr == 1) PG8_BAR;
    }
    PG8_WAIT_V(0);
    PG8_BAR;
#undef PG8_SA
#undef PG8_SB
#undef PG8_STAGE
#undef PG8_LDA
#undef PG8_LDB
#undef PG8_MMA
#undef PG8_WAIT_V
#undef PG8_WAIT_L
#undef PG8_BAR
#undef PG8_SCHED
}
}

struct EpiInProj {
    bf16_t* P; const float* qw; const float* kw; float qscale;
    __device__ __forceinline__ void operator()(const f32x4 (&acc)[2][2][4][2], const pg8::Unit& u, int wr, int wc, int fr_in, int fq_in, const pg8::Unit&, bool, int) const {
        int fr = fr_in, fq = fq_in; asm volatile("" : "+v"(fr), "+v"(fq));
        const int nai = u.h < 0 ? 2 : 1, rowh = u.pm * 256 + (u.h > 0 ? 128 : 0);
        const int tile = u.pn;
        const bool isq = tile < 2, isk = (tile == 2) && (wc < 2);
        const bool nrm = isq || isk;
        f32x4 gw[2][2];
#pragma unroll
        for (int bj = 0; bj < 2; ++bj)
#pragma unroll
            for (int n = 0; n < 2; ++n) {
                const int d = 32 * bj + 8 * fq + 4 * n;
                f32x4 w = (f32x4){1.f, 1.f, 1.f, 1.f};
                if (isq) w = *(const f32x4*)(qw + d) * qscale; else if (isk) w = *(const f32x4*)(kw + d);
                gw[bj][n] = w;
            }
        if (tile >= 5) {
            const int colc = COL_CU + 128 * (tile - 5) + 32 * wc + 8 * fq;
#pragma unroll
            for (int ai = 0; ai < 2; ++ai)
#pragma unroll
                for (int m = 0; m < 4; ++m) {
                    if (ai >= nai) continue;
                    const int row = rowh + ai * 128 + wr * 64 + m * 16 + fr;
                    const f32x4 a = acc[ai][0][m][0] * acc[ai][1][m][0], b = acc[ai][0][m][1] * acc[ai][1][m][1];
                    u32x4 w; w.x = cvtpk(a[0], a[1]); w.y = cvtpk(a[2], a[3]); w.z = cvtpk(b[0], b[1]); w.w = cvtpk(b[2], b[3]);
                    *(u32x4*)(P + (size_t)row * PW + colc) = w;
                }
            return;
        }
        const int colb = 256 * tile + 64 * wc + 8 * fq;
#pragma unroll
        for (int ai = 0; ai < 2; ++ai)
#pragma unroll
            for (int m = 0; m < 4; ++m) {
                if (ai >= nai) continue;
                    const int row = rowh + ai * 128 + wr * 64 + m * 16 + fr;
                f32x4 v[2][2];
#pragma unroll
                for (int bj = 0; bj < 2; ++bj)
#pragma unroll
                    for (int n = 0; n < 2; ++n) v[bj][n] = acc[ai][bj][m][n];
                if (nrm) {
                    float ss = 0.f;
#pragma unroll
                    for (int bj = 0; bj < 2; ++bj)
#pragma unroll
                        for (int n = 0; n < 2; ++n) { const f32x4 x = v[bj][n]; ss += (x[0] * x[0] + x[1] * x[1]) + (x[2] * x[2] + x[3] * x[3]); }
                    ss += __shfl_xor(ss, 16); ss += __shfl_xor(ss, 32);
                    const float r = fast_rsqrt(ss * (1.0f / 64.0f) + EPS);
#pragma unroll
                    for (int bj = 0; bj < 2; ++bj)
#pragma unroll
                        for (int n = 0; n < 2; ++n) v[bj][n] = v[bj][n] * r * gw[bj][n];
                }
                bf16_t* rowp = P + (size_t)row * PW + colb;
#pragma unroll
                for (int bj = 0; bj < 2; ++bj) {
                    u32x4 w; w.x = cvtpk(v[bj][0][0], v[bj][0][1]); w.y = cvtpk(v[bj][0][2], v[bj][0][3]); w.z = cvtpk(v[bj][1][0], v[bj][1][1]); w.w = cvtpk(v[bj][1][2], v[bj][1][3]);
                    *(u32x4*)(rowp + 32 * bj) = w;
                }
            }
    }
};

struct EpiOutProj {
    const float* x; bf16_t* xn; float* part;
    __device__ __forceinline__ void operator()(const f32x4 (&acc)[2][2][4][2], const pg8::Unit& u, int wr, int wc, int fr_in, int fq_in, const pg8::Unit&, bool, int) const {
        int fr = fr_in, fq = fq_in; asm volatile("" : "+v"(fr), "+v"(fq));
        const int col0 = u.pn * 256 + wc * 32 + 8 * fq;
#pragma unroll
        for (int ai = 0; ai < 2; ++ai)
#pragma unroll
            for (int m = 0; m < 4; ++m) {
                const int row = u.pm * 256 + ai * 128 + wr * 64 + m * 16 + fr;
                const size_t off = (size_t)row * DM + col0;
                float ss = 0.f;
#pragma unroll
                for (int bj = 0; bj < 2; ++bj) {
                    const f32x4 x0 = *(const f32x4*)(x + off + bj * 128), x1 = *(const f32x4*)(x + off + bj * 128 + 4);
                    const f32x4 a = x0 + acc[ai][bj][m][0], b = x1 + acc[ai][bj][m][1];
                    ss += (a[0] * a[0] + a[1] * a[1]) + (a[2] * a[2] + a[3] * a[3]) + (b[0] * b[0] + b[1] * b[1]) + (b[2] * b[2] + b[3] * b[3]);
                    u32x4 w; w.x = cvtpk(a[0], a[1]); w.y = cvtpk(a[2], a[3]); w.z = cvtpk(b[0], b[1]); w.w = cvtpk(b[2], b[3]);
                    *(u32x4*)(xn + off + bj * 128) = w;
                }
                ss += __shfl_xor(ss, 16); ss += __shfl_xor(ss, 32);
                if (fq == 0) part[(size_t)row * 16 + u.pn * 4 + wc] = ss;
            }
    }
};

struct EpiDown {
    const bf16_t* xn; float* out;
    __device__ __forceinline__ void operator()(const f32x4 (&acc)[2][2][4][2], const pg8::Unit& u, int wr, int wc, int fr_in, int fq_in, const pg8::Unit&, bool, int) const {
        int fr = fr_in, fq = fq_in; asm volatile("" : "+v"(fr), "+v"(fq));
        const int col0 = u.pn * 256 + wc * 32 + 8 * fq;
#pragma unroll
        for (int ai = 0; ai < 2; ++ai)
#pragma unroll
            for (int m = 0; m < 4; ++m) {
                const int row = u.pm * 256 + ai * 128 + wr * 64 + m * 16 + fr;
                const size_t off = (size_t)row * DM + col0;
#pragma unroll
                for (int bj = 0; bj < 2; ++bj) {
                    const u32x4 r = *(const u32x4*)(xn + off + bj * 128);
                    const f32x4 x0 = (f32x4){bflo(r.x), bfhi(r.x), bflo(r.y), bfhi(r.y)}, x1 = (f32x4){bflo(r.z), bfhi(r.z), bflo(r.w), bfhi(r.w)};
                    *(f32x4*)(out + off + bj * 128) = x0 + acc[ai][bj][m][0]; *(f32x4*)(out + off + bj * 128 + 4) = x1 + acc[ai][bj][m][1];
                }
            }
    }
};

__device__ __forceinline__ float dpp_shr1(float old, float src) { return __builtin_bit_cast(float, __builtin_amdgcn_update_dpp(__builtin_bit_cast(int, old), __builtin_bit_cast(int, src), 0x111, 0xf, 0xf, false)); }

struct EpiUpConv {
    bf16_t* act; const float* part; const float* cw; float* edge; LAS unsigned char* xch; mutable int rs_pm;
    __device__ __forceinline__ void operator()(f32x4 (&acc)[2][2][4][2], const pg8::Unit& u, int wr, int wc, int fr_in, int fq_in, const pg8::Unit& nxt, bool has_next, int ui) const {
        int fr = fr_in, fq = fq_in, tid = threadIdx.x;
        asm volatile("" : "+v"(fr), "+v"(fq), "+v"(tid));
        LAS f32x4* H = (LAS f32x4*)xch;
        LAS f32x4* CW = (LAS f32x4*)(xch + CWS_OFF) + (ui & 1) * 192;
        LAS f32x4* CWN = (LAS f32x4*)(xch + CWS_OFF) + ((ui + 1) & 1) * 192;
        LAS float* RS = (LAS float*)(xch + RS_OFF);
        const int nai = u.h < 0 ? 2 : 1, rbase = u.h > 0 ? 128 : 0;
        const int ctap = tid >> 6, cr = tid & 63;
        f32x4 cwv = (f32x4){0.f, 0.f, 0.f, 0.f}, cwn = (f32x4){0.f, 0.f, 0.f, 0.f};
        if (ui == 0 && tid < 192) cwv = *(const f32x4*)(cw + (size_t)ctap * NUP + (cr >> 5) * DFF + 128 * u.pn + 4 * (cr & 31));
        if (has_next && tid < 192) cwn = *(const f32x4*)(cw + (size_t)ctap * NUP + (cr >> 5) * DFF + 128 * nxt.pn + 4 * (cr & 31));
        if (u.pm != rs_pm) {
            if (tid < 256) {
                const float* pp = part + (size_t)(u.pm * 256 + tid) * 16;
                const f32x4 p0 = *(const f32x4*)pp, p1 = *(const f32x4*)(pp + 4), p2 = *(const f32x4*)(pp + 8), p3 = *(const f32x4*)(pp + 12);
                const float s = ((p0[0] + p0[1]) + (p0[2] + p0[3])) + ((p1[0] + p1[1]) + (p1[2] + p1[3])) + ((p2[0] + p2[1]) + (p2[2] + p2[3])) + ((p3[0] + p3[1]) + (p3[2] + p3[3]));
                RS[tid] = fast_rsqrt(s * (1.0f / (float)DM) + EPS);
            }
            asm volatile("s_waitcnt lgkmcnt(0)" ::: "memory"); __builtin_amdgcn_s_barrier(); asm volatile("" ::: "memory");
            rs_pm = u.pm;
        }
#pragma unroll
        for (int ai = 0; ai < 2; ++ai)
#pragma unroll
            for (int m = 0; m < 4; ++m) {
                if (ai >= nai) continue;
                const float rs = RS[rbase + ai * 128 + wr * 64 + 4 * fr + m];
#pragma unroll
                for (int bj = 0; bj < 2; ++bj)
#pragma unroll
                    for (int n = 0; n < 2; ++n) acc[ai][bj][m][n] = acc[ai][bj][m][n] * rs;
            }
        if (ui == 0 && tid < 192) CW[tid] = cwv;
        if (fr == 15) {
#pragma unroll
            for (int ai = 0; ai < 2; ++ai)
#pragma unroll
                for (int bj = 0; bj < 2; ++bj)
#pragma unroll
                    for (int n = 0; n < 2; ++n) {
                        H[((((ai * 2 + wr) * 4 + wc) * 2 + 0) * 4 + (bj * 2 + n)) * 4 + fq] = acc[ai][bj][2][n];
                        H[((((ai * 2 + wr) * 4 + wc) * 2 + 1) * 4 + (bj * 2 + n)) * 4 + fq] = acc[ai][bj][3][n];
                    }
        }
        const int colg = 128 * u.pn + 32 * wc + 8 * fq;
        if (wr == 0 && fr == 0) {
#pragma unroll
            for (int rsel = 0; rsel < 2; ++rsel) {
                float* e = edge + ((size_t)(u.pm * 8 + (u.h > 0 ? 6 : 0) + rsel)) * NUP + colg;
#pragma unroll
                for (int bj = 0; bj < 2; ++bj)
#pragma unroll
                    for (int n = 0; n < 2; ++n) *(f32x4*)(e + bj * DFF + 4 * n) = acc[0][bj][rsel][n];
            }
        }
        if (wr == 1 && fr == 15) {
#pragma unroll
            for (int rsel = 0; rsel < 2; ++rsel) {
                float* e = edge + ((size_t)(u.pm * 8 + (u.h == 0 ? 4 : 2) + rsel)) * NUP + colg;
#pragma unroll
                for (int bj = 0; bj < 2; ++bj)
#pragma unroll
                    for (int n = 0; n < 2; ++n) *(f32x4*)(e + bj * DFF + 4 * n) = (nai == 2) ? acc[1][bj][2 + rsel][n] : acc[0][bj][2 + rsel][n];
            }
        }
        asm volatile("s_waitcnt lgkmcnt(0)" ::: "memory"); __builtin_amdgcn_s_barrier(); asm volatile("" ::: "memory");
        const int cwi = 8 * wc + 2 * fq;
#pragma unroll
        for (int ai = 0; ai < 2; ++ai) {
            if (ai >= nai) continue;
            const int chunk = ai * 2 + wr;
            const int pch = chunk > 0 ? chunk - 1 : 0;
            u32x2 res[4][2];
#pragma unroll
            for (int n = 0; n < 2; ++n) {
                f32x4 y[2][4];
#pragma unroll
                for (int bj = 0; bj < 2; ++bj) {
                    const f32x4 w0 = CW[cwi + 32 * bj + n], w1 = CW[64 + cwi + 32 * bj + n], w2 = CW[128 + cwi + 32 * bj + n];
                    const f32x4 h62 = H[(((pch * 4 + wc) * 2 + 0) * 4 + (bj * 2 + n)) * 4 + fq], h63 = H[(((pch * 4 + wc) * 2 + 1) * 4 + (bj * 2 + n)) * 4 + fq];
                    const f32x4 x0 = acc[ai][bj][0][n], x1 = acc[ai][bj][1][n], x2 = acc[ai][bj][2][n], x3 = acc[ai][bj][3][n];
                    f32x4 p2, p3;
#pragma unroll
                    for (int j = 0; j < 4; ++j) { p2[j] = dpp_shr1(h62[j], x2[j]); p3[j] = dpp_shr1(h63[j], x3[j]); }
                    y[bj][0] = w2 * x0 + w1 * p3 + w0 * p2;
                    y[bj][1] = w2 * x1 + w1 * x0 + w0 * p3;
                    y[bj][2] = w2 * x2 + w1 * x1 + w0 * x0;
                    y[bj][3] = w2 * x3 + w1 * x2 + w0 * x1;
                }
#pragma unroll
                for (int m = 0; m < 4; ++m) {
                    const f32x4 g = y[0][m], v = y[1][m];
                    res[m][n].x = cvtpk(siluf(g[0]) * v[0], siluf(g[1]) * v[1]); res[m][n].y = cvtpk(siluf(g[2]) * v[2], siluf(g[3]) * v[3]);
                }
            }
#pragma unroll
            for (int m = 0; m < 4; ++m) {
                const int rt = ai * 128 + wr * 64 + 4 * fr + m;
                if (rt >= 2) { u32x4 w; w.x = res[m][0].x; w.y = res[m][0].y; w.z = res[m][1].x; w.w = res[m][1].y;
                    *(u32x4*)(act + (size_t)(u.pm * 256 + rbase + rt) * DFF + colg) = w; }
            }
        }
        if (has_next && tid < 192) CWN[tid] = cwn;
    }
};

__device__ __forceinline__ float wave_sum(float v) {
#pragma unroll
    for (int o = 1; o < 64; o <<= 1) v += __shfl_xor(v, o);
    return v;
}
template <int MODE>
__device__ __forceinline__ void p0_transpose_item(const float* W, int K, int N, bf16_t* WT, const float* gain, LAS float* scr, int item, int lane) {
    const int nblk = N / 32, kb = item / nblk, nb = item % nblk, k0 = 64 * kb, n0 = 32 * nb;
    int p0;
    if (MODE == 0) p0 = n0;
    else if (MODE == 1) {
        if (n0 < COL_C) { const int tile = n0 >> 8, c = n0 & 255, wc = c >> 6, bj = (c >> 5) & 1; p0 = tile * 256 + 128 * bj + 32 * wc; }
        else if (n0 < COL_U) { const int cc = n0 - COL_C; p0 = (5 + (cc >> 7)) * 256 + (cc & 127); }
        else { const int uc = n0 - COL_U; p0 = (5 + (uc >> 7)) * 256 + 128 + (uc & 127); }
    }
    else { if (n0 < DFF) p0 = 256 * (n0 >> 7) + (n0 & 127); else { const int n1 = n0 - DFF; p0 = 256 * (n1 >> 7) + 128 + (n1 & 127); } }
#pragma unroll 8
    for (int i = 0; i < 32; ++i) { const int kk = 2 * i + (lane >> 5); float v = W[(size_t)(k0 + kk) * N + n0 + (lane & 31)]; if (MODE == 2) v *= gain[k0 + kk]; scr[kk * 33 + (lane & 31)] = v; }
    asm volatile("s_waitcnt lgkmcnt(0)" ::: "memory");
    const int c = lane & 7;
#pragma unroll
    for (int j = 0; j < 4; ++j) { const int n = (lane >> 3) + 8 * j; const LAS float* s = scr + (8 * c) * 33 + n;
        u32x4 o; o.x = cvtpk(s[0 * 33], s[1 * 33]); o.y = cvtpk(s[2 * 33], s[3 * 33]); o.z = cvtpk(s[4 * 33], s[5 * 33]); o.w = cvtpk(s[6 * 33], s[7 * 33]);
        *(u32x4*)(WT + (size_t)(p0 + n) * K + k0 + 8 * c) = o; }
    asm volatile("s_waitcnt lgkmcnt(0)" ::: "memory");
}

namespace p2 {
constexpr int KPITCH = 72;
constexpr int KS_BYTES = 2 * 192 * KPITCH * 2;
constexpr int VT_OFF = KS_BYTES, VT_BYTES = 2 * 208 * KPITCH * 2;
constexpr int SS_OFF = VT_OFF + VT_BYTES;
static_assert(SS_OFF + 2048 <= RING_BYTES, "P2 LDS");
static_assert(XCH_OFF + RS_OFF + 1024 <= LDS_BYTES && MISC_OFF + 128 <= XCH_OFF + CWS_OFF, "exchange LDS map");
}

struct Args { const float* in[14]; float* out; unsigned char* ws; int cg_flag; int pad; };

__device__ __forceinline__ void p2_unit(LAS unsigned char* lds, const bf16_t* __restrict__ proj, bf16_t* __restrict__ mix, const float* __restrict__ sinks, const float* __restrict__ aw,
                                        const float* __restrict__ cmw, const float* __restrict__ cow, int unit, int tid, int lane, int wave) {
    using namespace p2;
    asm volatile("" : "+v"(tid), "+v"(lane));
    const int q0 = unit * 64;
    u32x4 kreg[6], vreg[6];
#pragma unroll
    for (int i = 0; i < 6; ++i) {
        const int id = i * 512 + tid, c = id & 7, rest = id >> 3, kv = rest / 192, kidx = rest - kv * 192, tok = q0 - 128 + kidx;
        kreg[i] = (u32x4){0u, 0u, 0u, 0u}; vreg[i] = (u32x4){0u, 0u, 0u, 0u};
        if (tok >= 0) { const bf16_t* src = proj + (size_t)tok * PW; kreg[i] = *(const u32x4*)(src + COL_K + 64 * kv + 8 * c); vreg[i] = *(const u32x4*)(src + COL_V + 64 * kv + 8 * c); }
    }
    __builtin_amdgcn_sched_barrier(0);
    const int c0 = 8 * lane, t0 = q0 + 8 * wave;
    u32x4 Cv[10], Bv[8];
#define P2_LOAD_CU(i) do { const int t_ = t0 - 2 + (i); Cv[i] = (u32x4){0u, 0u, 0u, 0u}; \
        if (t_ >= 0) Cv[i] = *(const u32x4*)(proj + (size_t)t_ * PW + c0 + COL_CU); } while (0)
#define P2_LOAD_B(i) do { Bv[i] = *(const u32x4*)(proj + (size_t)(t0 + (i)) * PW + c0 + COL_B); } while (0)
    P2_LOAD_CU(0); P2_LOAD_CU(1); P2_LOAD_CU(2); P2_LOAD_CU(3); P2_LOAD_CU(4); P2_LOAD_CU(5);
    P2_LOAD_B(0); P2_LOAD_B(1); P2_LOAD_B(2); P2_LOAD_B(3);
    float w0[8], w1[8], w2[8], gn[8];
#pragma unroll
    for (int hf = 0; hf < 2; ++hf) {
        const f32x4 a = *(const f32x4*)(cmw + c0 + 4 * hf), b = *(const f32x4*)(cmw + 512 + c0 + 4 * hf), c = *(const f32x4*)(cmw + 1024 + c0 + 4 * hf), d = *(const f32x4*)(cow + c0 + 4 * hf);
#pragma unroll
        for (int e = 0; e < 4; ++e) { w0[4 * hf + e] = a[e]; w1[4 * hf + e] = b[e]; w2[4 * hf + e] = c[e]; gn[4 * hf + e] = d[e]; }
    }
    __builtin_amdgcn_sched_barrier(0);
#pragma unroll
    for (int i = 0; i < 6; ++i) {
        const int id = i * 512 + tid, c = id & 7, rest = id >> 3, kv = rest / 192, kidx = rest - kv * 192;
        *(LAS u32x4*)(lds + ((kv * 192 + kidx) * KPITCH + 8 * c) * 2) = kreg[i];
        *(LAS u32x4*)(lds + VT_OFF + ((kv * 208 + kidx) * KPITCH + 8 * c) * 2) = vreg[i];
    }
    if (tid < 256) { const int kv = tid >> 7, r = (tid >> 3) & 15, c = tid & 7; *(LAS u32x4*)(lds + VT_OFF + ((kv * 208 + 192 + r) * KPITCH + 8 * c) * 2) = (u32x4){0u, 0u, 0u, 0u}; }
    __builtin_amdgcn_sched_barrier(0);
    P2_LOAD_CU(6); P2_LOAD_CU(7); P2_LOAD_CU(8); P2_LOAD_CU(9);
    P2_LOAD_B(4); P2_LOAD_B(5); P2_LOAD_B(6); P2_LOAD_B(7);
    __builtin_amdgcn_sched_barrier(0);
    float cm2[8], cm1[8];
#define P2_CONV_STEP(i) do { const u32x4 C = Cv[i]; float cu[8]; \
        cu[0] = bflo(C.x); cu[1] = bfhi(C.x); cu[2] = bflo(C.y); cu[3] = bfhi(C.y); cu[4] = bflo(C.z); cu[5] = bfhi(C.z); cu[6] = bflo(C.w); cu[7] = bfhi(C.w); \
        if ((i) >= 2) { const u32x4 B = Bv[(i) >= 2 ? (i) - 2 : 0]; \
            const float bb[8] = {bflo(B.x), bfhi(B.x), bflo(B.y), bfhi(B.y), bflo(B.z), bfhi(B.z), bflo(B.w), bfhi(B.w)}; \
            float cv[8]; float ss = 0.f; \
            _Pragma("unroll") for (int e = 0; e < 8; ++e) { const float y = w0[e] * cm2[e] + w1[e] * cm1[e] + w2[e] * cu[e]; cv[e] = bb[e] * y; ss += cv[e] * cv[e]; } \
            ss = wave_sum(ss); \
            const float r = fast_rsqrt(ss * (1.0f / 512.0f) + EPS); \
            u32x4 w; w.x = cvtpk(cv[0] * r * gn[0], cv[1] * r * gn[1]); w.y = cvtpk(cv[2] * r * gn[2], cv[3] * r * gn[3]); \
            w.z = cvtpk(cv[4] * r * gn[4], cv[5] * r * gn[5]); w.w = cvtpk(cv[6] * r * gn[6], cv[7] * r * gn[7]); \
            *(u32x4*)(mix + (size_t)(t0 + (i) - 2) * DM + 512 + c0) = w; } \
        _Pragma("unroll") for (int e = 0; e < 8; ++e) { cm2[e] = ((i) == 0) ? 0.f : cm1[e]; cm1[e] = cu[e]; } } while (0)
    P2_CONV_STEP(0); P2_CONV_STEP(1); P2_CONV_STEP(2); P2_CONV_STEP(3); P2_CONV_STEP(4); P2_CONV_STEP(5);
    __builtin_amdgcn_sched_barrier(0);
    const int h = wave, kvh = h >> 2, fr = lane & 15, fq = lane >> 4;
    bf16x8 Qf[4][2];
#pragma unroll
    for (int qt = 0; qt < 4; ++qt) {
        const bf16_t* qp = proj + (size_t)(q0 + 16 * qt + fr) * PW + 64 * h + 8 * fq;
        Qf[qt][0] = *(const bf16x8*)qp; Qf[qt][1] = *(const bf16x8*)(qp + 32);
    }
    const float sink2 = sinks[h] * LOG2E;
    __builtin_amdgcn_sched_barrier(0);
    P2_CONV_STEP(6); P2_CONV_STEP(7); P2_CONV_STEP(8); P2_CONV_STEP(9);
#undef P2_LOAD_CU
#undef P2_LOAD_B
#undef P2_CONV_STEP
    __syncthreads();
    LAS float* SSf = (LAS float*)(lds + SS_OFF);
    const bool early = q0 < 128;
    f32x4 O[4][4];
#pragma unroll
    for (int qt = 0; qt < 4; ++qt) {
        const bf16x8 Q0 = Qf[qt][0], Q1 = Qf[qt][1];
        f32x4 S[9];
#pragma unroll
        for (int kt = 0; kt < 9; ++kt) {
            const LAS unsigned char* kp = lds + ((kvh * 192 + 16 * (qt + kt) + fr) * KPITCH + 8 * fq) * 2;
            const bf16x8 K0 = *(const LAS bf16x8*)kp, K1 = *(const LAS bf16x8*)(kp + 64);
            f32x4 a = (f32x4){0.f, 0.f, 0.f, 0.f};
            a = __builtin_amdgcn_mfma_f32_16x16x32_bf16(K0, Q0, a, 0, 0, 0);
            a = __builtin_amdgcn_mfma_f32_16x16x32_bf16(K1, Q1, a, 0, 0, 0);
            S[kt] = a;
        }
        float mx = sink2;
#pragma unroll
        for (int kt = 0; kt < 9; ++kt)
#pragma unroll
            for (int j = 0; j < 4; ++j) {
                const int jt = q0 - 128 + 16 * (qt + kt) + 4 * fq + j;
                bool valid = early ? (jt >= 0) : true;
                if (kt == 0) valid = valid && (fr < 4 * fq + j);
                if (kt == 8) valid = valid && (fr >= 4 * fq + j);
                const float sv = valid ? S[kt][j] : -1e30f;
                S[kt][j] = sv; mx = fmaxf(mx, sv);
            }
        mx = fmaxf(mx, __shfl_xor(mx, 16)); mx = fmaxf(mx, __shfl_xor(mx, 32));
        float l = 0.f;
#pragma unroll
        for (int kt = 0; kt < 9; ++kt)
#pragma unroll
            for (int j = 0; j < 4; ++j) { const float p = __builtin_amdgcn_exp2f(S[kt][j] - mx); S[kt][j] = p; l += p; }
        l += __shfl_xor(l, 16); l += __shfl_xor(l, 32);
        l += __builtin_amdgcn_exp2f(sink2 - mx);
        const float inv = __builtin_amdgcn_rcpf(l);
        bf16x8 pb[5];
#pragma unroll
        for (int s2 = 0; s2 < 5; ++s2) {
            u32x4 w; w.x = cvtpk(S[2 * s2][0], S[2 * s2][1]); w.y = cvtpk(S[2 * s2][2], S[2 * s2][3]);
            if (2 * s2 + 1 < 9) { w.z = cvtpk(S[2 * s2 + 1 < 9 ? 2 * s2 + 1 : 0][0], S[2 * s2 + 1 < 9 ? 2 * s2 + 1 : 0][1]); w.w = cvtpk(S[2 * s2 + 1 < 9 ? 2 * s2 + 1 : 0][2], S[2 * s2 + 1 < 9 ? 2 * s2 + 1 : 0][3]); }
            else { w.z = 0u; w.w = 0u; }
            pb[s2] = __builtin_bit_cast(bf16x8, w);
        }
#pragma unroll
        for (int dt = 0; dt < 4; ++dt) {
            f32x4 o = (f32x4){0.f, 0.f, 0.f, 0.f};
#pragma unroll
            for (int s2 = 0; s2 < 5; ++s2) {
                const LAS unsigned char* vp = lds + VT_OFF + ((kvh * 208 + 16 * (qt + 2 * s2) + 4 * fq + (fr >> 2)) * KPITCH + 16 * dt + 4 * (fr & 3)) * 2;
                const s16x4 lo = __builtin_amdgcn_ds_read_tr16_b64_v4i16((LAS s16x4*)vp), hi = __builtin_amdgcn_ds_read_tr16_b64_v4i16((LAS s16x4*)(vp + 16 * KPITCH * 2));
                const bf16x8 vfb = (bf16x8){lo[0], lo[1], lo[2], lo[3], hi[0], hi[1], hi[2], hi[3]};
                o = __builtin_amdgcn_mfma_f32_16x16x32_bf16(vfb, pb[s2], o, 0, 0, 0);
            }
            O[qt][dt] = o * inv;
        }
        float ss = 0.f;
#pragma unroll
        for (int dt = 0; dt < 4; ++dt) { const f32x4 o = O[qt][dt]; ss += (o[0] * o[0] + o[1] * o[1]) + (o[2] * o[2] + o[3] * o[3]); }
        ss += __shfl_xor(ss, 16); ss += __shfl_xor(ss, 32);
        if (fq == 0) SSf[h * 64 + 16 * qt + fr] = ss;
    }
    __syncthreads();
#pragma unroll
    for (int qt = 0; qt < 4; ++qt) {
        float tot = 0.f;
#pragma unroll
        for (int hh = 0; hh < 8; ++hh) tot += SSf[hh * 64 + 16 * qt + fr];
        const float r = fast_rsqrt(tot * (1.0f / 512.0f) + EPS);
        bf16_t* mp = mix + (size_t)(q0 + 16 * qt + fr) * DM + 64 * h + 4 * fq;
#pragma unroll
        for (int dt = 0; dt < 4; ++dt) {
            const f32x4 g = *(const f32x4*)(aw + 64 * h + 16 * dt + 4 * fq);
            const f32x4 v = O[qt][dt] * r * g;
            u32x2 w; w.x = cvtpk(v[0], v[1]); w.y = cvtpk(v[2], v[3]);
            *(u32x2*)(mp + 16 * dt) = w;
        }
    }
    __syncthreads();
}

#define XB_TMO      128
#define XB_XCNT(j)  (256  + 64 * (j))
#define XB_XSUB(j)  (1280 + 64 * (j))
#define XB_XGEN(j)  (2304 + 64 * (j))
#define XB_TOP      3328
#define XB_TOPGEN   3392
#define XCD_BAR_WORDS 3456
#define XB_SPIN_CAP (1u << 18)
__device__ __forceinline__ unsigned xb_ld(unsigned* p)              { return __hip_atomic_load(p, __ATOMIC_RELAXED, __HIP_MEMORY_SCOPE_AGENT); }
__device__ __forceinline__ unsigned xb_add(unsigned* p, unsigned v) { return __hip_atomic_fetch_add(p, v, __ATOMIC_RELAXED, __HIP_MEMORY_SCOPE_AGENT); }
__device__ __forceinline__ unsigned xb_xcc_id() { return (unsigned)__builtin_amdgcn_s_getreg((3 << 11) | 20) & 0xFu; }
#define XB_SPIN(cond, bar) do { unsigned _sp = 0; while (cond) { __builtin_amdgcn_s_sleep(1); \
    if ((++_sp & 255u) == 0u) { if (xb_ld(&(bar)[XB_TMO])) break; if (_sp > XB_SPIN_CAP) { atomicAdd(&(bar)[XB_TMO], 1u); break; } } } } while (0)
struct XcdBarrier { unsigned* bar; unsigned x; volatile LAS unsigned* st; };
__device__ __forceinline__ XcdBarrier xcd_barrier_post(unsigned* bar, volatile LAS unsigned* st) {
    XcdBarrier b; b.bar = bar; b.x = xb_xcc_id(); b.st = st;
    if (threadIdx.x == 0) (void)xb_add(&bar[XB_XCNT(b.x)], 1u);
    return b;
}
__device__ __forceinline__ void xcd_barrier_complete(unsigned* bar, unsigned x, unsigned& nloc, unsigned& nx) {
    const unsigned G = gridDim.x * gridDim.y * gridDim.z;
    unsigned sum, cnt, mine, sp = 0u;
    for (;;) {
        sum = 0u; cnt = 0u; mine = 0u;
#pragma unroll
        for (unsigned j = 0; j < 16; ++j) { const unsigned c = xb_ld(&bar[XB_XCNT(j)]); sum += c; cnt += (c > 0u) ? 1u : 0u; mine = (j == x) ? c : mine; }
        if (sum == G) break;
        __builtin_amdgcn_s_sleep(1);
        if ((++sp & 255u) == 0u) { if (xb_ld(&bar[XB_TMO])) break; if (sp > XB_SPIN_CAP) { atomicAdd(&bar[XB_TMO], 1u); break; } }
    }
    nloc = mine > 0u ? mine : 1u; nx = cnt > 0u ? cnt : 1u;
}
__device__ __forceinline__ void xcd_barrier(const XcdBarrier& b) {
    asm volatile("s_waitcnt vmcnt(0)" ::: "memory");
    __syncthreads();
    if (threadIdx.x == 0) {
        unsigned* bar = b.bar;
        __builtin_amdgcn_s_waitcnt(0);
        unsigned nloc = b.st[0], nx = b.st[1];
        if (nloc == 0u) { xcd_barrier_complete(bar, b.x, nloc, nx); b.st[0] = nloc; b.st[1] = nx; }
        const unsigned old = xb_add(&bar[XB_XSUB(b.x)], 1u);
        const unsigned gen = old / nloc;
        if (old + 1u == (gen + 1u) * nloc) {
            __builtin_amdgcn_fence(__ATOMIC_RELEASE, "agent");
            asm volatile("s_waitcnt vmcnt(0)" ::: "memory");
            const unsigned og = xb_add(&bar[XB_TOP], 1u);
            const unsigned tg = og / nx;
            if (og + 1u == (tg + 1u) * nx) xb_add(&bar[XB_TOPGEN], 1u);
            else XB_SPIN(xb_ld(&bar[XB_TOPGEN]) == tg, bar);
            __builtin_amdgcn_fence(__ATOMIC_ACQUIRE, "agent");
            xb_add(&bar[XB_XGEN(b.x)], 1u);
            asm volatile("s_waitcnt vmcnt(0)" ::: "memory");
        } else {
            XB_SPIN(xb_ld(&bar[XB_XGEN(b.x)]) == gen, bar);
            __builtin_amdgcn_fence(__ATOMIC_ACQUIRE, "agent");
            asm volatile("s_waitcnt vmcnt(0)" ::: "memory");
        }
    }
    __syncthreads();
}

__device__ __forceinline__ void fix_rows(bf16_t* dst, const float* cw, const float* et, const float* e1, const float* e2, int f0) {
    float yv[2][8];
#pragma unroll
    for (int bj = 0; bj < 2; ++bj)
#pragma unroll
        for (int hf = 0; hf < 2; ++hf) {
            const int col = bj * DFF + f0 + 4 * hf;
            const f32x4 w0 = *(const f32x4*)(cw + col), w1 = *(const f32x4*)(cw + NUP + col), w2 = *(const f32x4*)(cw + 2 * NUP + col);
            const f32x4 z = (f32x4){0.f, 0.f, 0.f, 0.f};
            const f32x4 xt = *(const f32x4*)(et + col), x1 = e1 ? *(const f32x4*)(e1 + col) : z, x2 = e2 ? *(const f32x4*)(e2 + col) : z;
            const f32x4 y = w0 * x2 + w1 * x1 + w2 * xt;
#pragma unroll
            for (int e = 0; e < 4; ++e) yv[bj][4 * hf + e] = y[e];
        }
    u32x4 w; w.x = cvtpk(siluf(yv[0][0]) * yv[1][0], siluf(yv[0][1]) * yv[1][1]); w.y = cvtpk(siluf(yv[0][2]) * yv[1][2], siluf(yv[0][3]) * yv[1][3]);
    w.z = cvtpk(siluf(yv[0][4]) * yv[1][4], siluf(yv[0][5]) * yv[1][5]); w.w = cvtpk(siluf(yv[0][6]) * yv[1][6], siluf(yv[0][7]) * yv[1][7]);
    *(u32x4*)dst = w;
}

__device__ __forceinline__ void convert_w_in(const Args& a, bf16_t* Win_t, LAS float* scr, int gw, int NGW, int lane) {
    constexpr int I_IN = (DM / 64) * (NIN / 32);
    for (int it = gw; it < I_IN; it += NGW) p0_transpose_item<1>(a.in[2], DM, NIN, Win_t, nullptr, scr, it, lane);
}
__device__ __forceinline__ void convert_w_out_up(const Args& a, bf16_t* Wout_t, bf16_t* Wup_t, LAS float* scr, int gw, int NGW, int lane) {
    constexpr int I_OUT = (DM / 64) * (DM / 32), I_UP = (DM / 64) * (NUP / 32);
    for (int it = gw; it < I_OUT + I_UP; it += NGW) {
        if (it < I_OUT) p0_transpose_item<0>(a.in[9], DM, DM, Wout_t, nullptr, scr, it, lane);
        else p0_transpose_item<2>(a.in[11], DM, NUP, Wup_t, a.in[10], scr, it - I_OUT, lane);
    }
}
__device__ __forceinline__ void convert_w_down(const Args& a, bf16_t* Wdn_t, LAS float* scr, int gw, int NGW, int lane) {
    constexpr int I_DN = (DFF / 64) * (DM / 32);
    for (int it = gw; it < I_DN; it += NGW) p0_transpose_item<0>(a.in[13], DFF, DM, Wdn_t, nullptr, scr, it, lane);
}

__global__ void __launch_bounds__(512, 2) fwd_megakernel(Args a) {
    extern __shared__ __attribute__((aligned(16))) unsigned char lds_raw[];
    LAS unsigned char* lds = (LAS unsigned char*)lds_raw;
    cg::grid_group grid = cg::this_grid();
    const int tid = threadIdx.x, lane = tid & 63, wave = __builtin_amdgcn_readfirstlane(tid >> 6);
    const int G = gridDim.x, bx = blockIdx.x;
    unsigned char* ws = a.ws;
    volatile LAS unsigned* MISC = (volatile LAS unsigned*)(lds + MISC_OFF);
    if (tid < 32) MISC[tid] = 0u;
    __syncthreads();
    const XcdBarrier bar = xcd_barrier_post((unsigned*)(ws + WS_CTL), MISC + 8);
    if (a.cg_flag) grid.sync();
#define GRID_BAR() xcd_barrier(bar)
    const float* x = a.in[0]; float* out = a.out;
    bf16_t* Win_t = (bf16_t*)(ws + WS_WIN); bf16_t* Wout_t = (bf16_t*)(ws + WS_WOUT); bf16_t* Wup_t = (bf16_t*)(ws + WS_WUP); bf16_t* Wdn_t = (bf16_t*)(ws + WS_WDN);
    float* part = (float*)(ws + WS_PART); float* edge = (float*)(ws + WS_EDGE);
    bf16_t* XN = (bf16_t*)(ws + WS_XN); bf16_t* proj = (bf16_t*)(ws + WS_PROJ); bf16_t* mix = (bf16_t*)(ws + WS_MIX); bf16_t* act = (bf16_t*)(ws + WS_ACT);
    LAS float* scr = (LAS float*)(lds + wave * 16384);

    {
        const int gw = bx * 8 + wave, NGW = G * 8;
        convert_w_in(a, Win_t, scr, gw, NGW, lane);
        const float* gw1 = a.in[1];
        f32x4 gv[4];
#pragma unroll
        for (int j = 0; j < 4; ++j) gv[j] = *(const f32x4*)(gw1 + 4 * lane + 256 * j);
        for (int m = gw; m < SEQ; m += 4 * NGW) {
            f32x4 v[4][4];
#pragma unroll
            for (int rr = 0; rr < 4; ++rr) {
                const int mr = m + rr * NGW;
                const f32x4* xr = (const f32x4*)(x + (size_t)(mr < SEQ ? mr : m) * DM) + lane;
#pragma unroll
                for (int j = 0; j < 4; ++j) v[rr][j] = xr[64 * j];
            }
#pragma unroll
            for (int rr = 0; rr < 4; ++rr) {
                const int mr = m + rr * NGW;
                float s = 0.f;
#pragma unroll
                for (int j = 0; j < 4; ++j) s += (v[rr][j][0] * v[rr][j][0] + v[rr][j][1] * v[rr][j][1]) + (v[rr][j][2] * v[rr][j][2] + v[rr][j][3] * v[rr][j][3]);
                const float r = fast_rsqrt(wave_sum(s) * (1.0f / DM) + EPS);
                if (mr < SEQ) {
                    unsigned long long* o8 = (unsigned long long*)(XN + (size_t)mr * DM) + lane;
#pragma unroll
                    for (int j = 0; j < 4; ++j) { const f32x4 y = v[rr][j] * r * gv[j]; o8[64 * j] = (unsigned long long)cvtpk(y[0], y[1]) | ((unsigned long long)cvtpk(y[2], y[3]) << 32); }
                }
            }
        }
    }
    GRID_BAR();

    {
        pg8::Gemm g{XN, Win_t, SEQ, NIN, DM}; pg8::TailSplitOrder S; S.init(SEQ, NIN, G, bx);
        EpiInProj E{proj, a.in[3], a.in[4], 0.125f * LOG2E};
        pg8::gemm_phase<false, true>(lds, g, S, E);
        const int rem = (2 * S.rem > G) ? S.rem : 2 * S.rem;
        if (rem == 0) convert_w_out_up(a, Wout_t, Wup_t, scr, bx * 8 + wave, G * 8, lane);
        else if (bx >= rem) convert_w_out_up(a, Wout_t, Wup_t, scr, (bx - rem) * 8 + wave, (G - rem) * 8, lane);
        if (rem == 0) convert_w_down(a, Wdn_t, scr, bx * 8 + wave, G * 8, lane);
        else if (bx >= rem) convert_w_down(a, Wdn_t, scr, (bx - rem) * 8 + wave, (G - rem) * 8, lane);
    }
    GRID_BAR();

    {
        constexpr int NU = SEQ / 64, NPER = NU / 8;
        const bool xa = (G & 7) == 0;
        const int base = xa ? (bx & 7) * NPER : 0, j0 = xa ? (bx >> 3) : bx, js = xa ? (G >> 3) : G, jn = xa ? NPER : NU;
        for (int j = j0; j < jn; j += js) p2_unit(lds, proj, mix, a.in[5], a.in[7], a.in[6], a.in[8], base + j, tid, lane, wave);
    }
    GRID_BAR();

    {
        pg8::Gemm g{mix, Wout_t, SEQ, DM, DM}; pg8::StaticOrder S; S.init(SEQ, DM, G, bx);
        EpiOutProj E{x, XN, part};
        pg8::gemm_phase(lds, g, S, E);
    }
    GRID_BAR();

    {
        pg8::Gemm g{XN, Wup_t, SEQ, NUP, DM}; pg8::TailSplitOrder S; S.init(SEQ, NUP, G, bx);
        EpiUpConv E{act, part, a.in[12], edge, lds + XCH_OFF, -1};
        pg8::gemm_phase<true, true>(lds, g, S, E);
    }
    GRID_BAR();

    {
        pg8::Gemm g{act, Wdn_t, SEQ, DM, DFF}; pg8::StaticOrder S; S.init(SEQ, DM, G, bx);
        const float* cw = a.in[12];
        constexpr int NCG = DFF / 8;
        pg8::TailSplitOrder S4; S4.init(SEQ, NUP, G, bx);
        const bool split4 = S4.rem != 0 && 2 * S4.rem <= G;
        pg8::Unit fu;
        for (int i = 0; S.next(i, fu); ++i) {
            const int pm = fu.pm;
            for (int id = tid; id < 2 * NCG; id += 512) {
                const int rs = id / NCG, f0 = 8 * (id - rs * NCG);
                const float* et = edge + (size_t)(pm * 8 + rs) * NUP;
                const float* e1 = rs == 0 ? (pm > 0 ? edge + (size_t)((pm - 1) * 8 + 3) * NUP : nullptr) : edge + (size_t)(pm * 8 + 0) * NUP;
                const float* e2 = pm > 0 ? edge + (size_t)((pm - 1) * 8 + (rs == 0 ? 2 : 3)) * NUP : nullptr;
                fix_rows(act + (size_t)(pm * 256 + rs) * DFF + f0, cw, et, e1, e2, f0);
            }
            if (split4) {
                for (int pn4 = 0; pn4 < S4.b.nN; ++pn4) {
                    const int L = S4.b.index_of(pm, pn4);
                    if (L < S4.full * G) continue;
                    if (tid < 32) {
                        const int rs = tid >> 4, f0 = 128 * pn4 + 8 * (tid & 15);
                        const float* et = edge + (size_t)(pm * 8 + 6 + rs) * NUP;
                        const float* e1 = edge + (size_t)(pm * 8 + (rs == 0 ? 5 : 6)) * NUP;
                        const float* e2 = edge + (size_t)(pm * 8 + (rs == 0 ? 4 : 5)) * NUP;
                        fix_rows(act + (size_t)(pm * 256 + 128 + rs) * DFF + f0, cw, et, e1, e2, f0);
                    }
                }
            }
        }
        asm volatile("s_waitcnt vmcnt(0)" ::: "memory");
        __syncthreads();
        EpiDown E{XN, out};
        pg8::gemm_phase(lds, g, S, E);
    }
}

extern "C" void kernel_launch(void* const* d_in, const int* in_sizes, int n_in, void* d_out, int out_size, void* d_ws, size_t ws_size, hipStream_t stream) {
    static int grid_blocks = 0;
    if (grid_blocks == 0) {
        if (n_in != 14 || in_sizes[0] != SEQ * DM || out_size != SEQ * DM || ws_size < WS_END) { fprintf(stderr, "kernel_launch: unexpected shapes (n_in %d, ws %zu)\n", n_in, ws_size); grid_blocks = -1; return; }
        int dev = 0, cus = 0, per_cu = 0;
        hipGetDevice(&dev);
        hipDeviceGetAttribute(&cus, hipDeviceAttributeMultiprocessorCount, dev);
        if (hipFuncSetAttribute((const void*)fwd_megakernel, hipFuncAttributeMaxDynamicSharedMemorySize, LDS_BYTES) != hipSuccess) { fprintf(stderr, "kernel_launch: hipFuncSetAttribute failed\n"); grid_blocks = -1; return; }
        hipOccupancyMaxActiveBlocksPerMultiprocessor(&per_cu, (const void*)fwd_megakernel, 512, LDS_BYTES);
        if (per_cu < 1) per_cu = 1;
        grid_blocks = cus * 1;
        (void)per_cu; (void)hipGetLastError();
    }
    if (grid_blocks < 0) return;
    Args a{};
    for (int i = 0; i < 14; ++i) a.in[i] = (const float*)d_in[i];
    a.out = (float*)d_out; a.ws = (unsigned char*)d_ws;
    if (hipMemsetAsync((char*)d_ws + WS_CTL, 0, CTL_ZERO_BYTES, stream) != hipSuccess) { fprintf(stderr, "kernel_launch: memset failed\n"); return; }
    void* args[] = {&a};
    hipError_t e = hipLaunchCooperativeKernel((const void*)fwd_megakernel, dim3(grid_blocks), dim3(512), args, LDS_BYTES, stream);
    if (e != hipSuccess) fprintf(stderr, "cooperative launch failed: %s (grid %d)\n", hipGetErrorString(e), grid_blocks);
}
```

```cpp
#include <hip/hip_runtime.h>
#include <hip/hip_cooperative_groups.h>
#include <cstdio>
#include <cstdint>
namespace cg = cooperative_groups;

#define LAS __attribute__((address_space(3)))
typedef unsigned short bf16_t;
typedef short bf16x8 __attribute__((ext_vector_type(8)));
typedef float f32x4 __attribute__((ext_vector_type(4)));
typedef unsigned u32x4 __attribute__((ext_vector_type(4)));
typedef unsigned u32x2 __attribute__((ext_vector_type(2)));
typedef short s16x4 __attribute__((ext_vector_type(4)));

constexpr int SEQ = 16384, DM = 1024, NIN = 2304, DFF = 2816, NUP = 2 * DFF;
constexpr float EPS = 1e-6f;
constexpr float LOG2E = 1.4426950408889634f;
constexpr int COL_K = 512, COL_V = 640, COL_B = 768, COL_C = 1280, COL_U = 1792;
constexpr int PW = 1792, COL_CU = 1280;

constexpr size_t MiB = 1u << 20;
constexpr size_t WS_CTL = 0, CTL_ZERO_BYTES = 65536;
constexpr size_t WS_WIN = 1 * MiB;
constexpr size_t WS_WOUT = 6 * MiB;
constexpr size_t WS_WUP = 8 * MiB;
constexpr size_t WS_WDN = 20 * MiB;
constexpr size_t WS_PART = 26 * MiB;
constexpr size_t WS_EDGE = 170 * MiB;
constexpr size_t WS_XN = 34 * MiB;
constexpr size_t WS_PROJ = 66 * MiB;
constexpr size_t WS_MIX = 138 * MiB;
constexpr size_t WS_ACT = 66 * MiB;
constexpr size_t WS_END = 182 * MiB;

constexpr int RING_BYTES = 131072;
constexpr int XCH_OFF = RING_BYTES;
constexpr int CWS_OFF = 8192 + 256;
constexpr int RS_OFF = 8192 + 256 + 2 * 3072;
constexpr int MISC_OFF = XCH_OFF + 8192;
constexpr int LDS_BYTES = 147456;

typedef float f32x2_t __attribute__((ext_vector_type(2))); typedef __bf16 bf16x2_t __attribute__((ext_vector_type(2)));
__device__ __forceinline__ unsigned cvtpk(float lo, float hi) { f32x2_t v = {lo, hi}; bf16x2_t b = __builtin_convertvector(v, bf16x2_t); return __builtin_bit_cast(unsigned, b); }
__device__ __forceinline__ float bflo(unsigned u) { return __builtin_bit_cast(float, u << 16); }
__device__ __forceinline__ float bfhi(unsigned u) { return __builtin_bit_cast(float, u & 0xffff0000u); }
__device__ __forceinline__ float fast_rsqrt(float x) { return __builtin_amdgcn_rsqf(x); }
__device__ __forceinline__ float siluf(float g) { return g * __builtin_amdgcn_rcpf(1.0f + __builtin_amdgcn_exp2f(-g * LOG2E)); }

namespace pg8 {
constexpr int BM = 256, BK = 64, HALF = 128, HTB = HALF * BK * 2, STAGE_BYTES = 8 * HTB, NXCD = 8, WGM = 8;
__host__ __device__ __forceinline__ int lds_byte(int r, int c) { const int st = (r >> 4) * 2 + (c >> 5), rr = r & 15, cc = c & 31, ob = rr * 64 + cc * 2; return st * 1024 + (ob ^ (((ob >> 9) & 1) << 5)); }
__host__ __device__ __forceinline__ void stage_rc(int b, int& R, int& C) { const int st = b / 1024, sb = b % 1024, swz = sb ^ (((sb >> 9) & 1) << 5); R = (st >> 1) * 16 + swz / 64; C = (st & 1) * 32 + (swz % 64) / 2; }
__host__ __device__ __forceinline__ int perm32(int rho) { const int n = rho >> 4, i = rho & 15; return 8 * (i >> 2) + 4 * n + (i & 3); }

struct Unit { int pm, pn, h; };
struct Gemm { const bf16_t* A; const bf16_t* Bt; int M, N, K; };

struct StaticOrder {
    int nM, nN, nwg, G, c;
    __host__ __device__ void init(int M, int N, int G_, int c_) { nM = M / BM; nN = N / BM; nwg = nM * nN; G = G_; c = c_; }
    __host__ __device__ bool next(int i, Unit& u) const {
        const long L = (long)i * G + c; if (L >= nwg) return false;
        int wgid = (int)L; { const int q = nwg / NXCD, r = nwg % NXCD, xcd = wgid % NXCD, off = wgid / NXCD; wgid = (xcd < r ? xcd * (q + 1) : r * (q + 1) + (xcd - r) * q) + off; }
        const int nig = WGM * nN, gid = wgid / nig, fm = gid * WGM, gsz = (nM - fm) < WGM ? (nM - fm) : WGM;
        u.pm = fm + ((wgid % nig) % gsz); u.pn = (wgid % nig) / gsz; u.h = -1; return true;
    }
    __host__ __device__ int index_of(int pm, int pn) const {
        if (nwg % NXCD != 0) return -1;
        const int nig = WGM * nN, gid = pm / WGM, fm = gid * WGM, gsz = (nM - fm) < WGM ? (nM - fm) : WGM;
        const int wgid = gid * nig + pn * gsz + (pm - fm), q = nwg / NXCD;
        return (wgid % q) * NXCD + wgid / q;
    }
};
struct TailSplitOrder {
    StaticOrder b; int full, rem;
    __host__ __device__ void init(int M, int N, int G_, int c_) { b.init(M, N, G_, c_); full = b.nwg / G_; rem = b.nwg % G_; }
    __host__ __device__ bool team_form() const { return b.nwg % NXCD == 0 && b.nM == NXCD * WGM && b.G == 256 && rem != 0 && 2 * rem <= b.G && (full * (b.G / NXCD)) % WGM == 0; }
    __host__ __device__ bool next(int i, Unit& u) const {
        if (i < full || 2 * rem > b.G) return b.next(i, u);
        if (i > full) return false;
        if (team_form()) {
            const int x = b.c % NXCD, a = b.c / NXCD, p = a % WGM, s = a / WGM, q = b.nwg / NXCD, w0 = full * (b.G / NXCD), ntp = (q - w0) / WGM;
            if (s >= 2 * ntp) return false;
            const int w = w0 + WGM * (s >> 1) + p;
            u.pm = x * WGM + p; u.pn = w / WGM; u.h = s & 1; return true;
        }
        if (b.c >= 2 * rem) return false;
        StaticOrder t = b; t.c = b.c >> 1; if (!t.next(full, u)) return false;
        u.h = b.c & 1; return true;
    }
    __host__ __device__ int tail_busy() const {
        if (rem == 0) return 0;
        if (2 * rem > b.G) return rem;
        return 2 * rem;
    }
};

template <bool ROWPERM = false, bool HT = false, class Epi, class Sched>
__device__ __forceinline__ void gemm_phase(LAS unsigned char* lds, const Gemm g, const Sched& S, const Epi& E) {
    int tid_l = threadIdx.x; asm volatile("" : "+v"(tid_l));
    const int tid = tid_l, wid = __builtin_amdgcn_readfirstlane(tid >> 6), lane = tid & 63, wr = wid >> 2, wc = wid & 3, fr = lane & 15, fq = lane >> 4;
    const int K = g.K, nt = K / BK;
    unsigned voffA[2], voffB[2];
#pragma unroll
    for (int i = 0; i < 2; ++i) { int R, C; stage_rc(tid * 16 + i * 8192, R, C); const int Rb = (R & ~31) + perm32(R & 31);
        const int Ra = ROWPERM ? ((R & 64) | ((R & 15) << 2) | ((R >> 4) & 3)) : R;
        voffA[i] = (unsigned)(Ra * K + C) * 2u; voffB[i] = (unsigned)(Rb * K + C) * 2u; }
    const size_t kstep = (size_t)(BK * 2);
    const size_t hstep = (size_t)HALF * K * 2;
    const size_t tstep = 2 * hstep;
    const unsigned ldsw = (unsigned)wid * 1024u;
    const int aoff = lds_byte(wr * 64 + fr, fq * 8), boff = lds_byte(wc * 32 + fr, fq * 8);
#define PG8_SA(b, h) (((b) * 2 + (h)) * HTB)
#define PG8_SB(b, h) ((4 + (b) * 2 + (h)) * HTB)
#define PG8_STAGE(bufoff, gbase, voff) do { _Pragma("unroll") for (int _i = 0; _i < 2; ++_i) \
        __builtin_amdgcn_global_load_lds((const unsigned*)((const char*)(gbase) + (voff)[_i]), (LAS unsigned*)(lds + (bufoff) + ldsw + _i * 8192), 16, 0, 0); } while (0)
#define PG8_LDA(dst, b, h) do { _Pragma("unroll") for (int m = 0; m < 4; ++m) _Pragma("unroll") for (int k = 0; k < 2; ++k) dst[m][k] = *(const LAS bf16x8*)(lds + PG8_SA(b, h) + aoff + m * 2048 + k * 1024); } while (0)
#define PG8_LDB(dst, b, h) do { _Pragma("unroll") for (int n = 0; n < 2; ++n) _Pragma("unroll") for (int k = 0; k < 2; ++k) dst[n][k] = *(const LAS bf16x8*)(lds + PG8_SB(b, h) + boff + n * 2048 + k * 1024); } while (0)
#define PG8_MMA(ai, bj, At, Bt) do { __builtin_amdgcn_s_setprio(1); _Pragma("unroll") for (int m = 0; m < 4; ++m) _Pragma("unroll") for (int n = 0; n < 2; ++n) _Pragma("unroll") for (int k = 0; k < 2; ++k) \
        acc[ai][bj][m][n] = __builtin_amdgcn_mfma_f32_16x16x32_bf16(Bt[n][k], At[m][k], acc[ai][bj][m][n], 0, 0, 0); __builtin_amdgcn_s_setprio(0); } while (0)
#define PG8_WAIT_V(n) asm volatile("s_waitcnt vmcnt(" #n ")" ::: "memory")
#define PG8_WAIT_L(n) asm volatile("s_waitcnt lgkmcnt(" #n ")" ::: "memory")
#define PG8_BAR __builtin_amdgcn_s_barrier()
#define PG8_SCHED __builtin_amdgcn_sched_barrier(0)
    Unit cur, nxt; int ui = 0;
    if (!S.next(0, cur)) return;
    f32x4 acc[2][2][4][2];
#pragma unroll
    for (int a = 0; a < 2; ++a)
#pragma unroll
        for (int b = 0; b < 2; ++b)
#pragma unroll
            for (int m = 0; m < 4; ++m)
#pragma unroll
                for (int n = 0; n < 2; ++n) acc[a][b][m][n] = (f32x4){0.f, 0.f, 0.f, 0.f};
    bf16x8 At[4][2], B0[2][2], B1[2][2];
    const char* cA = (const char*)g.A + (size_t)cur.pm * tstep + ((HT && cur.h > 0) ? hstep : 0); const char* cB = (const char*)g.Bt + (size_t)cur.pn * tstep;
    size_t hsA = (HT && cur.h >= 0) ? 0 : hstep;
    PG8_STAGE(PG8_SB(0, 0), cB, voffB); PG8_STAGE(PG8_SB(0, 1), cB + hstep, voffB); PG8_STAGE(PG8_SA(0, 0), cA, voffA); PG8_STAGE(PG8_SA(0, 1), cA + hsA, voffA);
    if (wr == 1) PG8_BAR;
    PG8_WAIT_V(2); PG8_BAR;
    PG8_STAGE(PG8_SB(1, 0), cB + kstep, voffB); PG8_STAGE(PG8_SA(1, 0), cA + kstep, voffA); PG8_STAGE(PG8_SB(1, 1), cB + hstep + kstep, voffB);
    PG8_WAIT_V(6); PG8_BAR;
    for (;;) {
        const bool has_next = S.next(ui + 1, nxt);
        const char* nA = has_next ? (const char*)g.A + (size_t)nxt.pm * tstep + ((HT && nxt.h > 0) ? hstep : 0) : cA; const char* nB = has_next ? (const char*)g.Bt + (size_t)nxt.pn * tstep : cB;
        const size_t nhsA = has_next ? ((HT && nxt.h >= 0) ? (size_t)0 : hstep) : hsA;
        const bool full_u = !(HT && cur.h >= 0);
#define PG8_KLOOP(FULL) \
        for (int t = 0; t < nt; t += 2) { \
            const bool last = (t == nt - 2); \
            const char* a1 = cA + (size_t)(t + 1) * kstep; \
            const char* a2 = last ? nA : cA + (size_t)(t + 2) * kstep; const char* b2 = last ? nB : cB + (size_t)(t + 2) * kstep; \
            const char* a3 = a2 + kstep; const char* b3 = b2 + kstep; \
            const size_t hs2 = last ? nhsA : hsA; \
            PG8_LDB(B0, 0, 0); PG8_LDB(B1, 0, 1); PG8_SCHED; PG8_LDA(At, 0, 0); PG8_STAGE(PG8_SA(1, 1), a1 + hsA, voffA); \
            PG8_WAIT_V(8); PG8_WAIT_L(0); PG8_BAR; PG8_MMA(0, 0, At, B0); PG8_MMA(0, 1, At, B1); PG8_BAR; PG8_SCHED; \
            if (FULL) PG8_LDA(At, 0, 1); PG8_STAGE(PG8_SB(0, 0), b2, voffB); PG8_STAGE(PG8_SB(0, 1), b2 + hstep, voffB); PG8_STAGE(PG8_SA(0, 0), a2, voffA); \
            PG8_WAIT_V(8); PG8_WAIT_L(0); PG8_BAR; if (FULL) { PG8_MMA(1, 0, At, B0); PG8_MMA(1, 1, At, B1); } PG8_BAR; PG8_SCHED; \
            PG8_LDB(B0, 1, 0); PG8_LDB(B1, 1, 1); PG8_SCHED; PG8_LDA(At, 1, 0); PG8_STAGE(PG8_SA(0, 1), a2 + hs2, voffA); \
            PG8_WAIT_V(8); PG8_WAIT_L(0); PG8_BAR; PG8_MMA(0, 0, At, B0); PG8_MMA(0, 1, At, B1); PG8_BAR; PG8_SCHED; \
            if (FULL) PG8_LDA(At, 1, 1); PG8_STAGE(PG8_SB(1, 0), b3, voffB); PG8_STAGE(PG8_SB(1, 1), b3 + hstep, voffB); PG8_STAGE(PG8_SA(1, 0), a3, voffA); \
            PG8_WAIT_V(8); PG8_WAIT_L(0); PG8_BAR; if (FULL) { PG8_MMA(1, 0, At, B0); PG8_MMA(1, 1, At, B1); } PG8_BAR; PG8_SCHED; \
        }
        if (full_u) { PG8_KLOOP(true) } else { PG8_KLOOP(false) }
#undef PG8_KLOOP
        if (wr == 0) PG8_BAR;
        E(acc, cur, wr, wc, fr, fq, nxt, has_next, ui);
        if (!has_next) break;
#pragma unroll
        for (int a = 0; a < 2; ++a)
#pragma unroll
            for (int b = 0; b < 2; ++b)
#pragma unroll
                for (int m = 0; m < 4; ++m)
#pragma unroll
                    for (int n = 0; n < 2; ++n) acc[a][b][m][n] = (f32x4){0.f, 0.f, 0.f, 0.f};
        cur = nxt; cA = nA; cB = nB; hsA = nhsA; ++ui;
        if (wr == 1) PG8_BAR;
    }
    PG8_WAIT_V(0);
    PG8_BAR;
#undef PG8_SA
#undef PG8_SB
#undef PG8_STAGE
#undef PG8_LDA
#undef PG8_LDB
#undef PG8_MMA
#undef PG8_WAIT_V
#undef PG8_WAIT_L
#undef PG8_BAR
#undef PG8_SCHED
}
}

struct EpiInProj {
    bf16_t* P; const float* qw; const float* kw; float qscale;
    __device__ __forceinline__ void operator()(const f32x4 (&acc)[2][2][4][2], const pg8::Unit& u, int wr, int wc, int fr_in, int fq_in, const pg8::Unit&, bool, int) const {
        int fr = fr_in, fq = fq_in; asm volatile("" : "+v"(fr), "+v"(fq));
        const int nai = u.h < 0 ? 2 : 1, rowh = u.pm * 256 + (u.h > 0 ? 128 : 0);
        const int tile = u.pn;
        const bool isq = tile < 2, isk = (tile == 2) && (wc < 2);
        const bool nrm = isq || isk;
        f32x4 gw[2][2];
#pragma unroll
        for (int bj = 0; bj < 2; ++bj)
#pragma unroll
            for (int n = 0; n < 2; ++n) {
                const int d = 32 * bj + 8 * fq + 4 * n;
                f32x4 w = (f32x4){1.f, 1.f, 1.f, 1.f};
                if (isq) w = *(const f32x4*)(qw + d) * qscale; else if (isk) w = *(const f32x4*)(kw + d);
                gw[bj][n] = w;
            }
        if (tile >= 5) {
            const int colc = COL_CU + 128 * (tile - 5) + 32 * wc + 8 * fq;
#pragma unroll
            for (int ai = 0; ai < 2; ++ai)
#pragma unroll
                for (int m = 0; m < 4; ++m) {
                    if (ai >= nai) continue;
                    const int row = rowh + ai * 128 + wr * 64 + m * 16 + fr;
                    const f32x4 a = acc[ai][0][m][0] * acc[ai][1][m][0], b = acc[ai][0][m][1] * acc[ai][1][m][1];
                    u32x4 w; w.x = cvtpk(a[0], a[1]); w.y = cvtpk(a[2], a[3]); w.z = cvtpk(b[0], b[1]); w.w = cvtpk(b[2], b[3]);
                    *(u32x4*)(P + (size_t)row * PW + colc) = w;
                }
            return;
        }
        const int colb = 256 * tile + 64 * wc + 8 * fq;
#pragma unroll
        for (int ai = 0; ai < 2; ++ai)
#pragma unroll
            for (int m = 0; m < 4; ++m) {
                if (ai >= nai) continue;
                    const int row = rowh + ai * 128 + wr * 64 + m * 16 + fr;
                f32x4 v[2][2];
#pragma unroll
                for (int bj = 0; bj < 2; ++bj)
#pragma unroll
                    for (int n = 0; n < 2; ++n) v[bj][n] = acc[ai][bj][m][n];
                if (nrm) {
                    float ss = 0.f;
#pragma unroll
                    for (int bj = 0; bj < 2; ++bj)
#pragma unroll
                        for (int n = 0; n < 2; ++n) { const f32x4 x = v[bj][n]; ss += (x[0] * x[0] + x[1] * x[1]) + (x[2] * x[2] + x[3] * x[3]); }
                    ss += __shfl_xor(ss, 16); ss += __shfl_xor(ss, 32);
                    const float r = fast_rsqrt(ss * (1.0f / 64.0f) + EPS);
#pragma unroll
                    for (int bj = 0; bj < 2; ++bj)
#pragma unroll
                        for (int n = 0; n < 2; ++n) v[bj][n] = v[bj][n] * r * gw[bj][n];
                }
                bf16_t* rowp = P + (size_t)row * PW + colb;
#pragma unroll
                for (int bj = 0; bj < 2; ++bj) {
                    u32x4 w; w.x = cvtpk(v[bj][0][0], v[bj][0][1]); w.y = cvtpk(v[bj][0][2], v[bj][0][3]); w.z = cvtpk(v[bj][1][0], v[bj][1][1]); w.w = cvtpk(v[bj][1][2], v[bj][1][3]);
                    *(u32x4*)(rowp + 32 * bj) = w;
                }
            }
    }
};

struct EpiOutProj {
    const float* x; bf16_t* xn; float* part;
    __device__ __forceinline__ void operator()(const f32x4 (&acc)[2][2][4][2], const pg8::Unit& u, int wr, int wc, int fr_in, int fq_in, const pg8::Unit&, bool, int) const {
        int fr = fr_in, fq = fq_in; asm volatile("" : "+v"(fr), "+v"(fq));
        const int col0 = u.pn * 256 + wc * 32 + 8 * fq;
#pragma unroll
        for (int ai = 0; ai < 2; ++ai)
#pragma unroll
            for (int m = 0; m < 4; ++m) {
                const int row = u.pm * 256 + ai * 128 + wr * 64 + m * 16 + fr;
                const size_t off = (size_t)row * DM + col0;
                float ss = 0.f;
#pragma unroll
                for (int bj = 0; bj < 2; ++bj) {
                    const f32x4 x0 = *(const f32x4*)(x + off + bj * 128), x1 = *(const f32x4*)(x + off + bj * 128 + 4);
                    const f32x4 a = x0 + acc[ai][bj][m][0], b = x1 + acc[ai][bj][m][1];
                    ss += (a[0] * a[0] + a[1] * a[1]) + (a[2] * a[2] + a[3] * a[3]) + (b[0] * b[0] + b[1] * b[1]) + (b[2] * b[2] + b[3] * b[3]);
                    u32x4 w; w.x = cvtpk(a[0], a[1]); w.y = cvtpk(a[2], a[3]); w.z = cvtpk(b[0], b[1]); w.w = cvtpk(b[2], b[3]);
                    *(u32x4*)(xn + off + bj * 128) = w;
                }
                ss += __shfl_xor(ss, 16); ss += __shfl_xor(ss, 32);
                if (fq == 0) part[(size_t)row * 16 + u.pn * 4 + wc] = ss;
            }
    }
};

struct EpiDown {
    const bf16_t* xn; float* out;
    __device__ __forceinline__ void operator()(const f32x4 (&acc)[2][2][4][2], const pg8::Unit& u, int wr, int wc, int fr_in, int fq_in, const pg8::Unit&, bool, int) const {
        int fr = fr_in, fq = fq_in; asm volatile("" : "+v"(fr), "+v"(fq));
        const int col0 = u.pn * 256 + wc * 32 + 8 * fq;
#pragma unroll
        for (int ai = 0; ai < 2; ++ai)
#pragma unroll
            for (int m = 0; m < 4; ++m) {
                const int row = u.pm * 256 + ai * 128 + wr * 64 + m * 16 + fr;
                const size_t off = (size_t)row * DM + col0;
#pragma unroll
                for (int bj = 0; bj < 2; ++bj) {
                    const u32x4 r = *(const u32x4*)(xn + off + bj * 128);
                    const f32x4 x0 = (f32x4){bflo(r.x), bfhi(r.x), bflo(r.y), bfhi(r.y)}, x1 = (f32x4){bflo(r.z), bfhi(r.z), bflo(r.w), bfhi(r.w)};
                    *(f32x4*)(out + off + bj * 128) = x0 + acc[ai][bj][m][0]; *(f32x4*)(out + off + bj * 128 + 4) = x1 + acc[ai][bj][m][1];
                }
            }
    }
};

__device__ __forceinline__ float dpp_shr1(float old, float src) { return __builtin_bit_cast(float, __builtin_amdgcn_update_dpp(__builtin_bit_cast(int, old), __builtin_bit_cast(int, src), 0x111, 0xf, 0xf, false)); }

struct EpiUpConv {
    bf16_t* act; const float* part; const float* cw; float* edge; LAS unsigned char* xch; mutable int rs_pm;
    __device__ __forceinline__ void operator()(f32x4 (&acc)[2][2][4][2], const pg8::Unit& u, int wr, int wc, int fr_in, int fq_in, const pg8::Unit& nxt, bool has_next, int ui) const {
        int fr = fr_in, fq = fq_in, tid = threadIdx.x;
        asm volatile("" : "+v"(fr), "+v"(fq), "+v"(tid));
        LAS f32x4* H = (LAS f32x4*)xch;
        LAS f32x4* CW = (LAS f32x4*)(xch + CWS_OFF) + (ui & 1) * 192;
        LAS f32x4* CWN = (LAS f32x4*)(xch + CWS_OFF) + ((ui + 1) & 1) * 192;
        LAS float* RS = (LAS float*)(xch + RS_OFF);
        const int nai = u.h < 0 ? 2 : 1, rbase = u.h > 0 ? 128 : 0;
        const int ctap = tid >> 6, cr = tid & 63;
        f32x4 cwv = (f32x4){0.f, 0.f, 0.f, 0.f}, cwn = (f32x4){0.f, 0.f, 0.f, 0.f};
        if (ui == 0 && tid < 192) cwv = *(const f32x4*)(cw + (size_t)ctap * NUP + (cr >> 5) * DFF + 128 * u.pn + 4 * (cr & 31));
        if (has_next && tid < 192) cwn = *(const f32x4*)(cw + (size_t)ctap * NUP + (cr >> 5) * DFF + 128 * nxt.pn + 4 * (cr & 31));
        if (u.pm != rs_pm) {
            if (tid < 256) {
                const float* pp = part + (size_t)(u.pm * 256 + tid) * 16;
                const f32x4 p0 = *(const f32x4*)pp, p1 = *(const f32x4*)(pp + 4), p2 = *(const f32x4*)(pp + 8), p3 = *(const f32x4*)(pp + 12);
                const float s = ((p0[0] + p0[1]) + (p0[2] + p0[3])) + ((p1[0] + p1[1]) + (p1[2] + p1[3])) + ((p2[0] + p2[1]) + (p2[2] + p2[3])) + ((p3[0] + p3[1]) + (p3[2] + p3[3]));
                RS[tid] = fast_rsqrt(s * (1.0f / (float)DM) + EPS);
            }
            asm volatile("s_waitcnt lgkmcnt(0)" ::: "memory"); __builtin_amdgcn_s_barrier(); asm volatile("" ::: "memory");
            rs_pm = u.pm;
        }
#pragma unroll
        for (int ai = 0; ai < 2; ++ai)
#pragma unroll
            for (int m = 0; m < 4; ++m) {
                if (ai >= nai) continue;
                const float rs = RS[rbase + ai * 128 + wr * 64 + 4 * fr + m];
#pragma unroll
                for (int bj = 0; bj < 2; ++bj)
#pragma unroll
                    for (int n = 0; n < 2; ++n) acc[ai][bj][m][n] = acc[ai][bj][m][n] * rs;
            }
        if (ui == 0 && tid < 192) CW[tid] = cwv;
        if (fr == 15) {
#pragma unroll
            for (int ai = 0; ai < 2; ++ai)
#pragma unroll
                for (int bj = 0; bj < 2; ++bj)
#pragma unroll
                    for (int n = 0; n < 2; ++n) {
                        H[((((ai * 2 + wr) * 4 + wc) * 2 + 0) * 4 + (bj * 2 + n)) * 4 + fq] = acc[ai][bj][2][n];
                        H[((((ai * 2 + wr) * 4 + wc) * 2 + 1) * 4 + (bj * 2 + n)) * 4 + fq] = acc[ai][bj][3][n];
                    }
        }
        const int colg = 128 * u.pn + 32 * wc + 8 * fq;
        if (wr == 0 && fr == 0) {
#pragma unroll
            for (int rsel = 0; rsel < 2; ++rsel) {
                float* e = edge + ((size_t)(u.pm * 8 + (u.h > 0 ? 6 : 0) + rsel)) * NUP + colg;
#pragma unroll
                for (int bj = 0; bj < 2; ++bj)
#pragma unroll
                    for (int n = 0; n < 2; ++n) *(f32x4*)(e + bj * DFF + 4 * n) = acc[0][bj][rsel][n];
            }
        }
        if (wr == 1 && fr == 15) {
#pragma unroll
            for (int rsel = 0; rsel < 2; ++rsel) {
                float* e = edge + ((size_t)(u.pm * 8 + (u.h == 0 ? 4 : 2) + rsel)) * NUP + colg;
#pragma unroll
                for (int bj = 0; bj < 2; ++bj)
#pragma unroll
                    for (int n = 0; n < 2; ++n) *(f32x4*)(e + bj * DFF + 4 * n) = (nai == 2) ? acc[1][bj][2 + rsel][n] : acc[0][bj][2 + rsel][n];
            }
        }
        asm volatile("s_waitcnt lgkmcnt(0)" ::: "memory"); __builtin_amdgcn_s_barrier(); asm volatile("" ::: "memory");
        const int cwi = 8 * wc + 2 * fq;
#pragma unroll
        for (int ai = 0; ai < 2; ++ai) {
            if (ai >= nai) continue;
            const int chunk = ai * 2 + wr;
            const int pch = chunk > 0 ? chunk - 1 : 0;
            u32x2 res[4][2];
#pragma unroll
            for (int n = 0; n < 2; ++n) {
                f32x4 y[2][4];
#pragma unroll
                for (int bj = 0; bj < 2; ++bj) {
                    const f32x4 w0 = CW[cwi + 32 * bj + n], w1 = CW[64 + cwi + 32 * bj + n], w2 = CW[128 + cwi + 32 * bj + n];
                    const f32x4 h62 = H[(((pch * 4 + wc) * 2 + 0) * 4 + (bj * 2 + n)) * 4 + fq], h63 = H[(((pch * 4 + wc) * 2 + 1) * 4 + (bj * 2 + n)) * 4 + fq];
                    const f32x4 x0 = acc[ai][bj][0][n], x1 = acc[ai][bj][1][n], x2 = acc[ai][bj][2][n], x3 = acc[ai][bj][3][n];
                    f32x4 p2, p3;
#pragma unroll
                    for (int j = 0; j < 4; ++j) { p2[j] = dpp_shr1(h62[j], x2[j]); p3[j] = dpp_shr1(h63[j], x3[j]); }
                    y[bj][0] = w2 * x0 + w1 * p3 + w0 * p2;
                    y[bj][1] = w2 * x1 + w1 * x0 + w0 * p3;
                    y[bj][2] = w2 * x2 + w1 * x1 + w0 * x0;
                    y[bj][3] = w2 * x3 + w1 * x2 + w0 * x1;
                }
#pragma unroll
                for (int m = 0; m < 4; ++m) {
                    const f32x4 g = y[0][m], v = y[1][m];
                    res[m][n].x = cvtpk(siluf(g[0]) * v[0], siluf(g[1]) * v[1]); res[m][n].y = cvtpk(siluf(g[2]) * v[2], siluf(g[3]) * v[3]);
                }
            }
#pragma unroll
            for (int m = 0; m < 4; ++m) {
                const int rt = ai * 128 + wr * 64 + 4 * fr + m;
                if (rt >= 2) { u32x4 w; w.x = res[m][0].x; w.y = res[m][0].y; w.z = res[m][1].x; w.w = res[m][1].y;
                    *(u32x4*)(act + (size_t)(u.pm * 256 + rbase + rt) * DFF + colg) = w; }
            }
        }
        if (has_next && tid < 192) CWN[tid] = cwn;
    }
};

__device__ __forceinline__ float wave_sum(float v) {
#pragma unroll
    for (int o = 1; o < 64; o <<= 1) v += __shfl_xor(v, o);
    return v;
}
template <int MODE>
__device__ __forceinline__ void p0_transpose_item(const float* W, int K, int N, bf16_t* WT, const float* gain, LAS float* scr, int item, int lane) {
    const int nblk = N / 32, kb = item / nblk, nb = item % nblk, k0 = 64 * kb, n0 = 32 * nb;
    int p0;
    if (MODE == 0) p0 = n0;
    else if (MODE == 1) {
        if (n0 < COL_C) { const int tile = n0 >> 8, c = n0 & 255, wc = c >> 6, bj = (c >> 5) & 1; p0 = tile * 256 + 128 * bj + 32 * wc; }
        else if (n0 < COL_U) { const int cc = n0 - COL_C; p0 = (5 + (cc >> 7)) * 256 + (cc & 127); }
        else { const int uc = n0 - COL_U; p0 = (5 + (uc >> 7)) * 256 + 128 + (uc & 127); }
    }
    else { if (n0 < DFF) p0 = 256 * (n0 >> 7) + (n0 & 127); else { const int n1 = n0 - DFF; p0 = 256 * (n1 >> 7) + 128 + (n1 & 127); } }
#pragma unroll 8
    for (int i = 0; i < 32; ++i) { const int kk = 2 * i + (lane >> 5); float v = W[(size_t)(k0 + kk) * N + n0 + (lane & 31)]; if (MODE == 2) v *= gain[k0 + kk]; scr[kk * 33 + (lane & 31)] = v; }
    asm volatile("s_waitcnt lgkmcnt(0)" ::: "memory");
    const int c = lane & 7;
#pragma unroll
    for (int j = 0; j < 4; ++j) { const int n = (lane >> 3) + 8 * j; const LAS float* s = scr + (8 * c) * 33 + n;
        u32x4 o; o.x = cvtpk(s[0 * 33], s[1 * 33]); o.y = cvtpk(s[2 * 33], s[3 * 33]); o.z = cvtpk(s[4 * 33], s[5 * 33]); o.w = cvtpk(s[6 * 33], s[7 * 33]);
        *(u32x4*)(WT + (size_t)(p0 + n) * K + k0 + 8 * c) = o; }
    asm volatile("s_waitcnt lgkmcnt(0)" ::: "memory");
}

namespace p2 {
constexpr int KPITCH = 72;
constexpr int KS_BYTES = 2 * 192 * KPITCH * 2;
constexpr int VT_OFF = KS_BYTES, VT_BYTES = 2 * 208 * KPITCH * 2;
constexpr int SS_OFF = VT_OFF + VT_BYTES;
static_assert(SS_OFF + 2048 <= RING_BYTES, "P2 LDS");
static_assert(XCH_OFF + RS_OFF + 1024 <= LDS_BYTES && MISC_OFF + 128 <= XCH_OFF + CWS_OFF, "exchange LDS map");
}

struct Args { const float* in[14]; float* out; unsigned char* ws; int cg_flag; int pad; };

__device__ __forceinline__ void p2_unit(LAS unsigned char* lds, const bf16_t* __restrict__ proj, bf16_t* __restrict__ mix, const float* __restrict__ sinks, const float* __restrict__ aw,
                                        const float* __restrict__ cmw, const float* __restrict__ cow, int unit, int tid, int lane, int wave) {
    using namespace p2;
    asm volatile("" : "+v"(tid), "+v"(lane));
    const int q0 = unit * 64;
    u32x4 kreg[6], vreg[6];
#pragma unroll
    for (int i = 0; i < 6; ++i) {
        const int id = i * 512 + tid, c = id & 7, rest = id >> 3, kv = rest / 192, kidx = rest - kv * 192, tok = q0 - 128 + kidx;
        kreg[i] = (u32x4){0u, 0u, 0u, 0u}; vreg[i] = (u32x4){0u, 0u, 0u, 0u};
        if (tok >= 0) { const bf16_t* src = proj + (size_t)tok * PW; kreg[i] = *(const u32x4*)(src + COL_K + 64 * kv + 8 * c); vreg[i] = *(const u32x4*)(src + COL_V + 64 * kv + 8 * c); }
    }
    __builtin_amdgcn_sched_barrier(0);
    const int c0 = 8 * lane, t0 = q0 + 8 * wave;
    u32x4 Cv[10], Bv[8];
#define P2_LOAD_CU(i) do { const int t_ = t0 - 2 + (i); Cv[i] = (u32x4){0u, 0u, 0u, 0u}; \
        if (t_ >= 0) Cv[i] = *(const u32x4*)(proj + (size_t)t_ * PW + c0 + COL_CU); } while (0)
#define P2_LOAD_B(i) do { Bv[i] = *(const u32x4*)(proj + (size_t)(t0 + (i)) * PW + c0 + COL_B); } while (0)
    P2_LOAD_CU(0); P2_LOAD_CU(1); P2_LOAD_CU(2); P2_LOAD_CU(3); P2_LOAD_CU(4); P2_LOAD_CU(5);
    P2_LOAD_B(0); P2_LOAD_B(1); P2_LOAD_B(2); P2_LOAD_B(3);
    float w0[8], w1[8], w2[8], gn[8];
#pragma unroll
    for (int hf = 0; hf < 2; ++hf) {
        const f32x4 a = *(const f32x4*)(cmw + c0 + 4 * hf), b = *(const f32x4*)(cmw + 512 + c0 + 4 * hf), c = *(const f32x4*)(cmw + 1024 + c0 + 4 * hf), d = *(const f32x4*)(cow + c0 + 4 * hf);
#pragma unroll
        for (int e = 0; e < 4; ++e) { w0[4 * hf + e] = a[e]; w1[4 * hf + e] = b[e]; w2[4 * hf + e] = c[e]; gn[4 * hf + e] = d[e]; }
    }
    __builtin_amdgcn_sched_barrier(0);
#pragma unroll
    for (int i = 0; i < 6; ++i) {
        const int id = i * 512 + tid, c = id & 7, rest = id >> 3, kv = rest / 192, kidx = rest - kv * 192;
        *(LAS u32x4*)(lds + ((kv * 192 + kidx) * KPITCH + 8 * c) * 2) = kreg[i];
        *(LAS u32x4*)(lds + VT_OFF + ((kv * 208 + kidx) * KPITCH + 8 * c) * 2) = vreg[i];
    }
    if (tid < 256) { const int kv = tid >> 7, r = (tid >> 3) & 15, c = tid & 7; *(LAS u32x4*)(lds + VT_OFF + ((kv * 208 + 192 + r) * KPITCH + 8 * c) * 2) = (u32x4){0u, 0u, 0u, 0u}; }
    __builtin_amdgcn_sched_barrier(0);
    P2_LOAD_CU(6); P2_LOAD_CU(7); P2_LOAD_CU(8); P2_LOAD_CU(9);
    P2_LOAD_B(4); P2_LOAD_B(5); P2_LOAD_B(6); P2_LOAD_B(7);
    __builtin_amdgcn_sched_barrier(0);
    float cm2[8], cm1[8];
#define P2_CONV_STEP(i) do { const u32x4 C = Cv[i]; float cu[8]; \
        cu[0] = bflo(C.x); cu[1] = bfhi(C.x); cu[2] = bflo(C.y); cu[3] = bfhi(C.y); cu[4] = bflo(C.z); cu[5] = bfhi(C.z); cu[6] = bflo(C.w); cu[7] = bfhi(C.w); \
        if ((i) >= 2) { const u32x4 B = Bv[(i) >= 2 ? (i) - 2 : 0]; \
            const float bb[8] = {bflo(B.x), bfhi(B.x), bflo(B.y), bfhi(B.y), bflo(B.z), bfhi(B.z), bflo(B.w), bfhi(B.w)}; \
            float cv[8]; float ss = 0.f; \
            _Pragma("unroll") for (int e = 0; e < 8; ++e) { const float y = w0[e] * cm2[e] + w1[e] * cm1[e] + w2[e] * cu[e]; cv[e] = bb[e] * y; ss += cv[e] * cv[e]; } \
            ss = wave_sum(ss); \
            const float r = fast_rsqrt(ss * (1.0f / 512.0f) + EPS); \
            u32x4 w; w.x = cvtpk(cv[0] * r * gn[0], cv[1] * r * gn[1]); w.y = cvtpk(cv[2] * r * gn[2], cv[3] * r * gn[3]); \
            w.z = cvtpk(cv[4] * r * gn[4], cv[5] * r * gn[5]); w.w = cvtpk(cv[6] * r * gn[6], cv[7] * r * gn[7]); \
            *(u32x4*)(mix + (size_t)(t0 + (i) - 2) * DM + 512 + c0) = w; } \
        _Pragma("unroll") for (int e = 0; e < 8; ++e) { cm2[e] = ((i) == 0) ? 0.f : cm1[e]; cm1[e] = cu[e]; } } while (0)
    P2_CONV_STEP(0); P2_CONV_STEP(1); P2_CONV_STEP(2); P2_CONV_STEP(3); P2_CONV_STEP(4); P2_CONV_STEP(5);
    __builtin_amdgcn_sched_barrier(0);
    const int h = wave, kvh = h >> 2, fr = lane & 15, fq = lane >> 4;
    bf16x8 Qf[4][2];
#pragma unroll
    for (int qt = 0; qt < 4; ++qt) {
        const bf16_t* qp = proj + (size_t)(q0 + 16 * qt + fr) * PW + 64 * h + 8 * fq;
        Qf[qt][0] = *(const bf16x8*)qp; Qf[qt][1] = *(const bf16x8*)(qp + 32);
    }
    const float sink2 = sinks[h] * LOG2E;
    __builtin_amdgcn_sched_barrier(0);
    P2_CONV_STEP(6); P2_CONV_STEP(7); P2_CONV_STEP(8); P2_CONV_STEP(9);
#undef P2_LOAD_CU
#undef P2_LOAD_B
#undef P2_CONV_STEP
    __syncthreads();
    LAS float* SSf = (LAS float*)(lds + SS_OFF);
    const bool early = q0 < 128;
    f32x4 O[4][4];
#pragma unroll
    for (int qt = 0; qt < 4; ++qt) {
        const bf16x8 Q0 = Qf[qt][0], Q1 = Qf[qt][1];
        f32x4 S[9];
#pragma unroll
        for (int kt = 0; kt < 9; ++kt) {
            const LAS unsigned char* kp = lds + ((kvh * 192 + 16 * (qt + kt) + fr) * KPITCH + 8 * fq) * 2;
            const bf16x8 K0 = *(const LAS bf16x8*)kp, K1 = *(const LAS bf16x8*)(kp + 64);
            f32x4 a = (f32x4){0.f, 0.f, 0.f, 0.f};
            a = __builtin_amdgcn_mfma_f32_16x16x32_bf16(K0, Q0, a, 0, 0, 0);
            a = __builtin_amdgcn_mfma_f32_16x16x32_bf16(K1, Q1, a, 0, 0, 0);
            S[kt] = a;
        }
        float mx = sink2;
#pragma unroll
        for (int kt = 0; kt < 9; ++kt)
#pragma unroll
            for (int j = 0; j < 4; ++j) {
                const int jt = q0 - 128 + 16 * (qt + kt) + 4 * fq + j;
                bool valid = early ? (jt >= 0) : true;
                if (kt == 0) valid = valid && (fr < 4 * fq + j);
                if (kt == 8) valid = valid && (fr >= 4 * fq + j);
                const float sv = valid ? S[kt][j] : -1e30f;
                S[kt][j] = sv; mx = fmaxf(mx, sv);
            }
        mx = fmaxf(mx, __shfl_xor(mx, 16)); mx = fmaxf(mx, __shfl_xor(mx, 32));
        float l = 0.f;
#pragma unroll
        for (int kt = 0; kt < 9; ++kt)
#pragma unroll
            for (int j = 0; j < 4; ++j) { const float p = __builtin_amdgcn_exp2f(S[kt][j] - mx); S[kt][j] = p; l += p; }
        l += __shfl_xor(l, 16); l += __shfl_xor(l, 32);
        l += __builtin_amdgcn_exp2f(sink2 - mx);
        const float inv = __builtin_amdgcn_rcpf(l);
        bf16x8 pb[5];
#pragma unroll
        for (int s2 = 0; s2 < 5; ++s2) {
            u32x4 w; w.x = cvtpk(S[2 * s2][0], S[2 * s2][1]); w.y = cvtpk(S[2 * s2][2], S[2 * s2][3]);
            if (2 * s2 + 1 < 9) { w.z = cvtpk(S[2 * s2 + 1 < 9 ? 2 * s2 + 1 : 0][0], S[2 * s2 + 1 < 9 ? 2 * s2 + 1 : 0][1]); w.w = cvtpk(S[2 * s2 + 1 < 9 ? 2 * s2 + 1 : 0][2], S[2 * s2 + 1 < 9 ? 2 * s2 + 1 : 0][3]); }
            else { w.z = 0u; w.w = 0u; }
            pb[s2] = __builtin_bit_cast(bf16x8, w);
        }
#pragma unroll
        for (int dt = 0; dt < 4; ++dt) {
            f32x4 o = (f32x4){0.f, 0.f, 0.f, 0.f};
#pragma unroll
            for (int s2 = 0; s2 < 5; ++s2) {
                const LAS unsigned char* vp = lds + VT_OFF + ((kvh * 208 + 16 * (qt + 2 * s2) + 4 * fq + (fr >> 2)) * KPITCH + 16 * dt + 4 * (fr & 3)) * 2;
                const s16x4 lo = __builtin_amdgcn_ds_read_tr16_b64_v4i16((LAS s16x4*)vp), hi = __builtin_amdgcn_ds_read_tr16_b64_v4i16((LAS s16x4*)(vp + 16 * KPITCH * 2));
                const bf16x8 vfb = (bf16x8){lo[0], lo[1], lo[2], lo[3], hi[0], hi[1], hi[2], hi[3]};
                o = __builtin_amdgcn_mfma_f32_16x16x32_bf16(vfb, pb[s2], o, 0, 0, 0);
            }
            O[qt][dt] = o * inv;
        }
        float ss = 0.f;
#pragma unroll
        for (int dt = 0; dt < 4; ++dt) { const f32x4 o = O[qt][dt]; ss += (o[0] * o[0] + o[1] * o[1]) + (o[2] * o[2] + o[3] * o[3]); }
        ss += __shfl_xor(ss, 16); ss += __shfl_xor(ss, 32);
        if (fq == 0) SSf[h * 64 + 16 * qt + fr] = ss;
    }
    __syncthreads();
#pragma unroll
    for (int qt = 0; qt < 4; ++qt) {
        float tot = 0.f;
#pragma unroll
        for (int hh = 0; hh < 8; ++hh) tot += SSf[hh * 64 + 16 * qt + fr];
        const float r = fast_rsqrt(tot * (1.0f / 512.0f) + EPS);
        bf16_t* mp = mix + (size_t)(q0 + 16 * qt + fr) * DM + 64 * h + 4 * fq;
#pragma unroll
        for (int dt = 0; dt < 4; ++dt) {
            const f32x4 g = *(const f32x4*)(aw + 64 * h + 16 * dt + 4 * fq);
            const f32x4 v = O[qt][dt] * r * g;
            u32x2 w; w.x = cvtpk(v[0], v[1]); w.y = cvtpk(v[2], v[3]);
            *(u32x2*)(mp + 16 * dt) = w;
        }
    }
    __syncthreads();
}

#define XB_TMO      128
#define XB_XCNT(j)  (256  + 64 * (j))
#define XB_XSUB(j)  (1280 + 64 * (j))
#define XB_XGEN(j)  (2304 + 64 * (j))
#define XB_TOP      3328
#define XB_TOPGEN   3392
#define XCD_BAR_WORDS 3456
#define XB_SPIN_CAP (1u << 18)
__device__ __forceinline__ unsigned xb_ld(unsigned* p)              { return __hip_atomic_load(p, __ATOMIC_RELAXED, __HIP_MEMORY_SCOPE_AGENT); }
__device__ __forceinline__ unsigned xb_add(unsigned* p, unsigned v) { return __hip_atomic_fetch_add(p, v, __ATOMIC_RELAXED, __HIP_MEMORY_SCOPE_AGENT); }
__device__ __forceinline__ unsigned xb_xcc_id() { return (unsigned)__builtin_amdgcn_s_getreg((3 << 11) | 20) & 0xFu; }
#define XB_SPIN(cond, bar) do { unsigned _sp = 0; while (cond) { __builtin_amdgcn_s_sleep(1); \
    if ((++_sp & 255u) == 0u) { if (xb_ld(&(bar)[XB_TMO])) break; if (_sp > XB_SPIN_CAP) { atomicAdd(&(bar)[XB_TMO], 1u); break; } } } } while (0)
struct XcdBarrier { unsigned* bar; unsigned x; volatile LAS unsigned* st; };
__device__ __forceinline__ XcdBarrier xcd_barrier_post(unsigned* bar, volatile LAS unsigned* st) {
    XcdBarrier b; b.bar = bar; b.x = xb_xcc_id(); b.st = st;
    if (threadIdx.x == 0) (void)xb_add(&bar[XB_XCNT(b.x)], 1u);
    return b;
}
__device__ __forceinline__ void xcd_barrier_complete(unsigned* bar, unsigned x, unsigned& nloc, unsigned& nx) {
    const unsigned G = gridDim.x * gridDim.y * gridDim.z;
    unsigned sum, cnt, mine, sp = 0u;
    for (;;) {
        sum = 0u; cnt = 0u; mine = 0u;
#pragma unroll
        for (unsigned j = 0; j < 16; ++j) { const unsigned c = xb_ld(&bar[XB_XCNT(j)]); sum += c; cnt += (c > 0u) ? 1u : 0u; mine = (j == x) ? c : mine; }
        if (sum == G) break;
        __builtin_amdgcn_s_sleep(1);
        if ((++sp & 255u) == 0u) { if (xb_ld(&bar[XB_TMO])) break; if (sp > XB_SPIN_CAP) { atomicAdd(&bar[XB_TMO], 1u); break; } }
    }
    nloc = mine > 0u ? mine : 1u; nx = cnt > 0u ? cnt : 1u;
}
__device__ __forceinline__ void xcd_barrier(const XcdBarrier& b) {
    asm volatile("s_waitcnt vmcnt(0)" ::: "memory");
    __syncthreads();
    if (threadIdx.x == 0) {
        unsigned* bar = b.bar;
        __builtin_amdgcn_s_waitcnt(0);
        unsigned nloc = b.st[0], nx = b.st[1];
        if (nloc == 0u) { xcd_barrier_complete(bar, b.x, nloc, nx); b.st[0] = nloc; b.st[1] = nx; }
        const unsigned old = xb_add(&bar[XB_XSUB(b.x)], 1u);
        const unsigned gen = old / nloc;
        if (old + 1u == (gen + 1u) * nloc) {
            __builtin_amdgcn_fence(__ATOMIC_RELEASE, "agent");
            asm volatile("s_waitcnt vmcnt(0)" ::: "memory");
            const unsigned og = xb_add(&bar[XB_TOP], 1u);
            const unsigned tg = og / nx;
            if (og + 1u == (tg + 1u) * nx) xb_add(&bar[XB_TOPGEN], 1u);
            else XB_SPIN(xb_ld(&bar[XB_TOPGEN]) == tg, bar);
            __builtin_amdgcn_fence(__ATOMIC_ACQUIRE, "agent");
            xb_add(&bar[XB_XGEN(b.x)], 1u);
            asm volatile("s_waitcnt vmcnt(0)" ::: "memory");
        } else {
            XB_SPIN(xb_ld(&bar[XB_XGEN(b.x)]) == gen, bar);
            __builtin_amdgcn_fence(__ATOMIC_ACQUIRE, "agent");
            asm volatile("s_waitcnt vmcnt(0)" ::: "memory");
        }
    }
    __syncthreads();
}

__device__ __forceinline__ void fix_rows(bf16_t* dst, const float* cw, const float* et, const float* e1, const float* e2, int f0) {
    float yv[2][8];
#pragma unroll
    for (int bj = 0; bj < 2; ++bj)
#pragma unroll
        for (int hf = 0; hf < 2; ++hf) {
            const int col = bj * DFF + f0 + 4 * hf;
            const f32x4 w0 = *(const f32x4*)(cw + col), w1 = *(const f32x4*)(cw + NUP + col), w2 = *(const f32x4*)(cw + 2 * NUP + col);
            const f32x4 z = (f32x4){0.f, 0.f, 0.f, 0.f};
            const f32x4 xt = *(const f32x4*)(et + col), x1 = e1 ? *(const f32x4*)(e1 + col) : z, x2 = e2 ? *(const f32x4*)(e2 + col) : z;
            const f32x4 y = w0 * x2 + w1 * x1 + w2 * xt;
#pragma unroll
            for (int e = 0; e < 4; ++e) yv[bj][4 * hf + e] = y[e];
        }
    u32x4 w; w.x = cvtpk(siluf(yv[0][0]) * yv[1][0], siluf(yv[0][1]) * yv[1][1]); w.y = cvtpk(siluf(yv[0][2]) * yv[1][2], siluf(yv[0][3]) * yv[1][3]);
    w.z = cvtpk(siluf(yv[0][4]) * yv[1][4], siluf(yv[0][5]) * yv[1][5]); w.w = cvtpk(siluf(yv[0][6]) * yv[1][6], siluf(yv[0][7]) * yv[1][7]);
    *(u32x4*)dst = w;
}

__device__ __forceinline__ void convert_w_in(const Args& a, bf16_t* Win_t, LAS float* scr, int gw, int NGW, int lane) {
    constexpr int I_IN = (DM / 64) * (NIN / 32);
    for (int it = gw; it < I_IN; it += NGW) p0_transpose_item<1>(a.in[2], DM, NIN, Win_t, nullptr, scr, it, lane);
}
__device__ __forceinline__ void convert_w_out_up(const Args& a, bf16_t* Wout_t, bf16_t* Wup_t, LAS float* scr, int gw, int NGW, int lane) {
    constexpr int I_OUT = (DM / 64) * (DM / 32), I_UP = (DM / 64) * (NUP / 32);
    for (int it = gw; it < I_OUT + I_UP; it += NGW) {
        if (it < I_OUT) p0_transpose_item<0>(a.in[9], DM, DM, Wout_t, nullptr, scr, it, lane);
        else p0_transpose_item<2>(a.in[11], DM, NUP, Wup_t, a.in[10], scr, it - I_OUT, lane);
    }
}
__device__ __forceinline__ void convert_w_down(const Args& a, bf16_t* Wdn_t, LAS float* scr, int gw, int NGW, int lane) {
    constexpr int I_DN = (DFF / 64) * (DM / 32);
    for (int it = gw; it < I_DN; it += NGW) p0_transpose_item<0>(a.in[13], DFF, DM, Wdn_t, nullptr, scr, it, lane);
}

__global__ void __launch_bounds__(512, 2) fwd_megakernel(Args a) {
    extern __shared__ __attribute__((aligned(16))) unsigned char lds_raw[];
    LAS unsigned char* lds = (LAS unsigned char*)lds_raw;
    cg::grid_group grid = cg::this_grid();
    const int tid = threadIdx.x, lane = tid & 63, wave = __builtin_amdgcn_readfirstlane(tid >> 6);
    const int G = gridDim.x, bx = blockIdx.x;
    unsigned char* ws = a.ws;
    volatile LAS unsigned* MISC = (volatile LAS unsigned*)(lds + MISC_OFF);
    if (tid < 32) MISC[tid] = 0u;
    __syncthreads();
    const XcdBarrier bar = xcd_barrier_post((unsigned*)(ws + WS_CTL), MISC + 8);
    if (a.cg_flag) grid.sync();
#define GRID_BAR() xcd_barrier(bar)
    const float* x = a.in[0]; float* out = a.out;
    bf16_t* Win_t = (bf16_t*)(ws + WS_WIN); bf16_t* Wout_t = (bf16_t*)(ws + WS_WOUT); bf16_t* Wup_t = (bf16_t*)(ws + WS_WUP); bf16_t* Wdn_t = (bf16_t*)(ws + WS_WDN);
    float* part = (float*)(ws + WS_PART); float* edge = (float*)(ws + WS_EDGE);
    bf16_t* XN = (bf16_t*)(ws + WS_XN); bf16_t* proj = (bf16_t*)(ws + WS_PROJ); bf16_t* mix = (bf16_t*)(ws + WS_MIX); bf16_t* act = (bf16_t*)(ws + WS_ACT);
    LAS float* scr = (LAS float*)(lds + wave * 16384);

    {
        const int gw = bx * 8 + wave, NGW = G * 8;
        convert_w_in(a, Win_t, scr, gw, NGW, lane);
        const float* gw1 = a.in[1];
        f32x4 gv[4];
#pragma unroll
        for (int j = 0; j < 4; ++j) gv[j] = *(const f32x4*)(gw1 + 4 * lane + 256 * j);
        for (int m = gw; m < SEQ; m += 4 * NGW) {
            f32x4 v[4][4];
#pragma unroll
            for (int rr = 0; rr < 4; ++rr) {
                const int mr = m + rr * NGW;
                const f32x4* xr = (const f32x4*)(x + (size_t)(mr < SEQ ? mr : m) * DM) + lane;
#pragma unroll
                for (int j = 0; j < 4; ++j) v[rr][j] = xr[64 * j];
            }
#pragma unroll
            for (int rr = 0; rr < 4; ++rr) {
                const int mr = m + rr * NGW;
                float s = 0.f;
#pragma unroll
                for (int j = 0; j < 4; ++j) s += (v[rr][j][0] * v[rr][j][0] + v[rr][j][1] * v[rr][j][1]) + (v[rr][j][2] * v[rr][j][2] + v[rr][j][3] * v[rr][j][3]);
                const float r = fast_rsqrt(wave_sum(s) * (1.0f / DM) + EPS);
                if (mr < SEQ) {
                    unsigned long long* o8 = (unsigned long long*)(XN + (size_t)mr * DM) + lane;
#pragma unroll
                    for (int j = 0; j < 4; ++j) { const f32x4 y = v[rr][j] * r * gv[j]; o8[64 * j] = (unsigned long long)cvtpk(y[0], y[1]) | ((unsigned long long)cvtpk(y[2], y[3]) << 32); }
                }
            }
        }
    }
    GRID_BAR();

    {
        pg8::Gemm g{XN, Win_t, SEQ, NIN, DM}; pg8::TailSplitOrder S; S.init(SEQ, NIN, G, bx);
        EpiInProj E{proj, a.in[3], a.in[4], 0.125f * LOG2E};
        pg8::gemm_phase<false, true>(lds, g, S, E);
        const int rem = (2 * S.rem > G) ? S.rem : 2 * S.rem;
        if (rem == 0) convert_w_out_up(a, Wout_t, Wup_t, scr, bx * 8 + wave, G * 8, lane);
        else if (bx >= rem) convert_w_out_up(a, Wout_t, Wup_t, scr, (bx - rem) * 8 + wave, (G - rem) * 8, lane);
    }
    GRID_BAR();

    {
        constexpr int NU = SEQ / 64, NPER = NU / 8;
        const bool xa = (G & 7) == 0;
        const int base = xa ? (bx & 7) * NPER : 0, j0 = xa ? (bx >> 3) : bx, js = xa ? (G >> 3) : G, jn = xa ? NPER : NU;
        for (int j = j0; j < jn; j += js) p2_unit(lds, proj, mix, a.in[5], a.in[7], a.in[6], a.in[8], base + j, tid, lane, wave);
    }
    GRID_BAR();

    {
        pg8::Gemm g{mix, Wout_t, SEQ, DM, DM}; pg8::StaticOrder S; S.init(SEQ, DM, G, bx);
        EpiOutProj E{x, XN, part};
        pg8::gemm_phase(lds, g, S, E);
    }
    GRID_BAR();

    {
        pg8::Gemm g{XN, Wup_t, SEQ, NUP, DM}; pg8::StaticOrder S; S.init(SEQ, NUP, G, bx);
        EpiUpConv E{act, part, a.in[12], edge, lds + XCH_OFF, -1};
        pg8::gemm_phase<true, false>(lds, g, S, E);
        const int rem = S.nwg % G;
        if (rem == 0) convert_w_down(a, Wdn_t, scr, bx * 8 + wave, G * 8, lane);
        else if (bx >= rem) convert_w_down(a, Wdn_t, scr, (bx - rem) * 8 + wave, (G - rem) * 8, lane);
    }
    GRID_BAR();

    {
        pg8::Gemm g{act, Wdn_t, SEQ, DM, DFF}; pg8::StaticOrder S; S.init(SEQ, DM, G, bx);
        const float* cw = a.in[12];
        constexpr int NCG = DFF / 8;
        pg8::TailSplitOrder S4; S4.init(SEQ, NUP, G, bx);
        const bool split4 = false;
        pg8::Unit fu;
        for (int i = 0; S.next(i, fu); ++i) {
            const int pm = fu.pm;
            for (int id = tid; id < 2 * NCG; id += 512) {
                const int rs = id / NCG, f0 = 8 * (id - rs * NCG);
                const float* et = edge + (size_t)(pm * 8 + rs) * NUP;
                const float* e1 = rs == 0 ? (pm > 0 ? edge + (size_t)((pm - 1) * 8 + 3) * NUP : nullptr) : edge + (size_t)(pm * 8 + 0) * NUP;
                const float* e2 = pm > 0 ? edge + (size_t)((pm - 1) * 8 + (rs == 0 ? 2 : 3)) * NUP : nullptr;
                fix_rows(act + (size_t)(pm * 256 + rs) * DFF + f0, cw, et, e1, e2, f0);
            }
            if (split4) {
                for (int pn4 = 0; pn4 < S4.b.nN; ++pn4) {
                    const int L = S4.b.index_of(pm, pn4);
                    if (L < S4.full * G) continue;
                    if (tid < 32) {
                        const int rs = tid >> 4, f0 = 128 * pn4 + 8 * (tid & 15);
                        const float* et = edge + (size_t)(pm * 8 + 6 + rs) * NUP;
                        const float* e1 = edge + (size_t)(pm * 8 + (rs == 0 ? 5 : 6)) * NUP;
                        const float* e2 = edge + (size_t)(pm * 8 + (rs == 0 ? 4 : 5)) * NUP;
                        fix_rows(act + (size_t)(pm * 256 + 128 + rs) * DFF + f0, cw, et, e1, e2, f0);
                    }
                }
            }
        }
        asm volatile("s_waitcnt vmcnt(0)" ::: "memory");
        __syncthreads();
        EpiDown E{XN, out};
        pg8::gemm_phase(lds, g, S, E);
    }
}

extern "C" void kernel_launch(void* const* d_in, const int* in_sizes, int n_in, void* d_out, int out_size, void* d_ws, size_t ws_size, hipStream_t stream) {
    static int grid_blocks = 0;
    if (grid_blocks == 0) {
        if (n_in != 14 || in_sizes[0] != SEQ * DM || out_size != SEQ * DM || ws_size < WS_END) { fprintf(stderr, "kernel_launch: unexpected shapes (n_in %d, ws %zu)\n", n_in, ws_size); grid_blocks = -1; return; }
        int dev = 0, cus = 0, per_cu = 0;
        hipGetDevice(&dev);
        hipDeviceGetAttribute(&cus, hipDeviceAttributeMultiprocessorCount, dev);
        if (hipFuncSetAttribute((const void*)fwd_megakernel, hipFuncAttributeMaxDynamicSharedMemorySize, LDS_BYTES) != hipSuccess) { fprintf(stderr, "kernel_launch: hipFuncSetAttribute failed\n"); grid_blocks = -1; return; }
        hipOccupancyMaxActiveBlocksPerMultiprocessor(&per_cu, (const void*)fwd_megakernel, 512, LDS_BYTES);
        if (per_cu < 1) per_cu = 1;
        grid_blocks = cus * 1;
        (void)per_cu; (void)hipGetLastError();
    }
    if (grid_blocks < 0) return;
    Args a{};
    for (int i = 0; i < 14; ++i) a.in[i] = (const float*)d_in[i];
    a.out = (float*)d_out; a.ws = (unsigned char*)d_ws;
    if (hipMemsetAsync((char*)d_ws + WS_CTL, 0, CTL_ZERO_BYTES, stream) != hipSuccess) { fprintf(stderr, "kernel_launch: memset failed\n"); return; }
    void* args[] = {&a};
    hipError_t e = hipLaunchCooperativeKernel((const void*)fwd_megakernel, dim3(grid_blocks), dim3(512), args, LDS_BYTES, stream);
    if (e != hipSuccess) fprintf(stderr, "cooperative launch failed: %s (grid %d)\n", hipGetErrorString(e), grid_blocks);
}
```

```cpp
#include <hip/hip_runtime.h>
#include <hip/hip_cooperative_groups.h>
#include <cstdio>
#include <cstdint>
namespace cg = cooperative_groups;

#define LAS __attribute__((address_space(3)))
typedef unsigned short bf16_t;
typedef short bf16x8 __attribute__((ext_vector_type(8)));
typedef float f32x4 __attribute__((ext_vector_type(4)));
typedef unsigned u32x4 __attribute__((ext_vector_type(4)));
typedef unsigned u32x2 __attribute__((ext_vector_type(2)));
typedef short s16x4 __attribute__((ext_vector_type(4)));

constexpr int SEQ = 16384, DM = 1024, NIN = 2304, DFF = 2816, NUP = 2 * DFF;
constexpr float EPS = 1e-6f;
constexpr float LOG2E = 1.4426950408889634f;
constexpr int COL_K = 512, COL_V = 640, COL_B = 768, COL_C = 1280, COL_U = 1792;
constexpr int PW = 1792, COL_CU = 1280;

constexpr size_t MiB = 1u << 20;
constexpr size_t WS_CTL = 0, CTL_ZERO_BYTES = 65536;
constexpr size_t WS_WIN = 1 * MiB;
constexpr size_t WS_WOUT = 6 * MiB;
constexpr size_t WS_WUP = 8 * MiB;
constexpr size_t WS_WDN = 20 * MiB;
constexpr size_t WS_PART = 26 * MiB;
constexpr size_t WS_EDGE = 170 * MiB;
constexpr size_t WS_XN = 34 * MiB;
constexpr size_t WS_PROJ = 66 * MiB;
constexpr size_t WS_MIX = 138 * MiB;
constexpr size_t WS_ACT = 66 * MiB;
constexpr size_t WS_END = 182 * MiB;

constexpr int RING_BYTES = 131072;
constexpr int XCH_OFF = RING_BYTES;
constexpr int CWS_OFF = 8192 + 256;
constexpr int RS_OFF = 8192 + 256 + 2 * 3072;
constexpr int MISC_OFF = XCH_OFF + 8192;
constexpr int LDS_BYTES = 147456;

typedef float f32x2_t __attribute__((ext_vector_type(2))); typedef __bf16 bf16x2_t __attribute__((ext_vector_type(2)));
__device__ __forceinline__ unsigned cvtpk(float lo, float hi) { f32x2_t v = {lo, hi}; bf16x2_t b = __builtin_convertvector(v, bf16x2_t); return __builtin_bit_cast(unsigned, b); }
__device__ __forceinline__ float bflo(unsigned u) { return __builtin_bit_cast(float, u << 16); }
__device__ __forceinline__ float bfhi(unsigned u) { return __builtin_bit_cast(float, u & 0xffff0000u); }
__device__ __forceinline__ float fast_rsqrt(float x) { return __builtin_amdgcn_rsqf(x); }
__device__ __forceinline__ float siluf(float g) { return g * __builtin_amdgcn_rcpf(1.0f + __builtin_amdgcn_exp2f(-g * LOG2E)); }

namespace pg8 {
constexpr int BM = 256, BK = 64, HALF = 128, HTB = HALF * BK * 2, STAGE_BYTES = 8 * HTB, NXCD = 8, WGM = 8;
__host__ __device__ __forceinline__ int lds_byte(int r, int c) { const int st = (r >> 4) * 2 + (c >> 5), rr = r & 15, cc = c & 31, ob = rr * 64 + cc * 2; return st * 1024 + (ob ^ (((ob >> 9) & 1) << 5)); }
__host__ __device__ __forceinline__ void stage_rc(int b, int& R, int& C) { const int st = b / 1024, sb = b % 1024, swz = sb ^ (((sb >> 9) & 1) << 5); R = (st >> 1) * 16 + swz / 64; C = (st & 1) * 32 + (swz % 64) / 2; }
__host__ __device__ __forceinline__ int perm32(int rho) { const int n = rho >> 4, i = rho & 15; return 8 * (i >> 2) + 4 * n + (i & 3); }

struct Unit { int pm, pn, h; };
struct Gemm { const bf16_t* A; const bf16_t* Bt; int M, N, K; };

struct StaticOrder {
    int nM, nN, nwg, G, c;
    __host__ __device__ void init(int M, int N, int G_, int c_) { nM = M / BM; nN = N / BM; nwg = nM * nN; G = G_; c = c_; }
    __host__ __device__ bool next(int i, Unit& u) const {
        const long L = (long)i * G + c; if (L >= nwg) return false;
        int wgid = (int)L; { const int q = nwg / NXCD, r = nwg % NXCD, xcd = wgid % NXCD, off = wgid / NXCD; wgid = (xcd < r ? xcd * (q + 1) : r * (q + 1) + (xcd - r) * q) + off; }
        const int nig = WGM * nN, gid = wgid / nig, fm = gid * WGM, gsz = (nM - fm) < WGM ? (nM - fm) : WGM;
        u.pm = fm + ((wgid % nig) % gsz); u.pn = (wgid % nig) / gsz; u.h = -1; return true;
    }
    __host__ __device__ int index_of(int pm, int pn) const {
        if (nwg % NXCD != 0) return -1;
        const int nig = WGM * nN, gid = pm / WGM, fm = gid * WGM, gsz = (nM - fm) < WGM ? (nM - fm) : WGM;
        const int wgid = gid * nig + pn * gsz + (pm - fm), q = nwg / NXCD;
        return (wgid % q) * NXCD + wgid / q;
    }
};
struct TailSplitOrder {
    StaticOrder b; int full, rem;
    __host__ __device__ void init(int M, int N, int G_, int c_) { b.init(M, N, G_, c_); full = b.nwg / G_; rem = b.nwg % G_; }
    __host__ __device__ bool team_form() const { return b.nwg % NXCD == 0 && b.nM == NXCD * WGM && b.G == 256 && rem != 0 && 2 * rem <= b.G && (full * (b.G / NXCD)) % WGM == 0; }
    __host__ __device__ bool next(int i, Unit& u) const {
        if (i < full || 2 * rem > b.G) return b.next(i, u);
        if (i > full) return false;
        if (team_form()) {
            const int x = b.c % NXCD, a = b.c / NXCD, p = a % WGM, s = a / WGM, q = b.nwg / NXCD, w0 = full * (b.G / NXCD), ntp = (q - w0) / WGM;
            if (s >= 2 * ntp) return false;
            const int w = w0 + WGM * (s >> 1) + p;
            u.pm = x * WGM + p; u.pn = w / WGM; u.h = s & 1; return true;
        }
        if (b.c >= 2 * rem) return false;
        StaticOrder t = b; t.c = b.c >> 1; if (!t.next(full, u)) return false;
        u.h = b.c & 1; return true;
    }
    __host__ __device__ int tail_busy() const {
        if (rem == 0) return 0;
        if (2 * rem > b.G) return rem;
        return 2 * rem;
    }
};

template <bool ROWPERM = false, bool HT = false, class Epi, class Sched>
__device__ __forceinline__ void gemm_phase(LAS unsigned char* lds, const Gemm g, const Sched& S, const Epi& E) {
    int tid_l = threadIdx.x; asm volatile("" : "+v"(tid_l));
    const int tid = tid_l, wid = __builtin_amdgcn_readfirstlane(tid >> 6), lane = tid & 63, wr = wid >> 2, wc = wid & 3, fr = lane & 15, fq = lane >> 4;
    const int K = g.K, nt = K / BK;
    unsigned voffA[2], voffB[2];
#pragma unroll
    for (int i = 0; i < 2; ++i) { int R, C; stage_rc(tid * 16 + i * 8192, R, C); const int Rb = (R & ~31) + perm32(R & 31);
        const int Ra = ROWPERM ? ((R & 64) | ((R & 15) << 2) | ((R >> 4) & 3)) : R;
        voffA[i] = (unsigned)(Ra * K + C) * 2u; voffB[i] = (unsigned)(Rb * K + C) * 2u; }
    const size_t kstep = (size_t)(BK * 2);
    const size_t hstep = (size_t)HALF * K * 2;
    const size_t tstep = 2 * hstep;
    const unsigned ldsw = (unsigned)wid * 1024u;
    const int aoff = lds_byte(wr * 64 + fr, fq * 8), boff = lds_byte(wc * 32 + fr, fq * 8);
#define PG8_SA(b, h) (((b) * 2 + (h)) * HTB)
#define PG8_SB(b, h) ((4 + (b) * 2 + (h)) * HTB)
#define PG8_STAGE(bufoff, gbase, voff) do { _Pragma("unroll") for (int _i = 0; _i < 2; ++_i) \
        __builtin_amdgcn_global_load_lds((const unsigned*)((const char*)(gbase) + (voff)[_i]), (LAS unsigned*)(lds + (bufoff) + ldsw + _i * 8192), 16, 0, 0); } while (0)
#define PG8_LDA(dst, b, h) do { _Pragma("unroll") for (int m = 0; m < 4; ++m) _Pragma("unroll") for (int k = 0; k < 2; ++k) dst[m][k] = *(const LAS bf16x8*)(lds + PG8_SA(b, h) + aoff + m * 2048 + k * 1024); } while (0)
#define PG8_LDB(dst, b, h) do { _Pragma("unroll") for (int n = 0; n < 2; ++n) _Pragma("unroll") for (int k = 0; k < 2; ++k) dst[n][k] = *(const LAS bf16x8*)(lds + PG8_SB(b, h) + boff + n * 2048 + k * 1024); } while (0)
#define PG8_MMA(ai, bj, At, Bt) do { __builtin_amdgcn_s_setprio(1); _Pragma("unroll") for (int m = 0; m < 4; ++m) _Pragma("unroll") for (int n = 0; n < 2; ++n) _Pragma("unroll") for (int k = 0; k < 2; ++k) \
        acc[ai][bj][m][n] = __builtin_amdgcn_mfma_f32_16x16x32_bf16(Bt[n][k], At[m][k], acc[ai][bj][m][n], 0, 0, 0); __builtin_amdgcn_s_setprio(0); } while (0)
#define PG8_WAIT_V(n) asm volatile("s_waitcnt vmcnt(" #n ")" ::: "memory")
#define PG8_WAIT_L(n) asm volatile("s_waitcnt lgkmcnt(" #n ")" ::: "memory")
#define PG8_BAR __builtin_amdgcn_s_barrier()
#define PG8_SCHED __builtin_amdgcn_sched_barrier(0)
    Unit cur, nxt; int ui = 0;
    if (!S.next(0, cur)) return;
    f32x4 acc[2][2][4][2];
#pragma unroll
    for (int a = 0; a < 2; ++a)
#pragma unroll
        for (int b = 0; b < 2; ++b)
#pragma unroll
            for (int m = 0; m < 4; ++m)
#pragma unroll
                for (int n = 0; n < 2; ++n) acc[a][b][m][n] = (f32x4){0.f, 0.f, 0.f, 0.f};
    bf16x8 At[4][2], B0[2][2], B1[2][2];
    const char* cA = (const char*)g.A + (size_t)cur.pm * tstep + ((HT && cur.h > 0) ? hstep : 0); const char* cB = (const char*)g.Bt + (size_t)cur.pn * tstep;
    size_t hsA = (HT && cur.h >= 0) ? 0 : hstep;
    PG8_STAGE(PG8_SB(0, 0), cB, voffB); PG8_STAGE(PG8_SB(0, 1), cB + hstep, voffB); PG8_STAGE(PG8_SA(0, 0), cA, voffA); PG8_STAGE(PG8_SA(0, 1), cA + hsA, voffA);
    if (wr == 1) PG8_BAR;
    PG8_WAIT_V(2); PG8_BAR;
    PG8_STAGE(PG8_SB(1, 0), cB + kstep, voffB); PG8_STAGE(PG8_SA(1, 0), cA + kstep, voffA); PG8_STAGE(PG8_SB(1, 1), cB + hstep + kstep, voffB);
    PG8_WAIT_V(6); PG8_BAR;
    for (;;) {
        const bool has_next = S.next(ui + 1, nxt);
        const char* nA = has_next ? (const char*)g.A + (size_t)nxt.pm * tstep + ((HT && nxt.h > 0) ? hstep : 0) : cA; const char* nB = has_next ? (const char*)g.Bt + (size_t)nxt.pn * tstep : cB;
        const size_t nhsA = has_next ? ((HT && nxt.h >= 0) ? (size_t)0 : hstep) : hsA;
        const bool full_u = !(HT && cur.h >= 0);
#define PG8_KLOOP(FULL) \
        for (int t = 0; t < nt; t += 2) { \
            const bool last = (t == nt - 2); \
            const char* a1 = cA + (size_t)(t + 1) * kstep; \
            const char* a2 = last ? nA : cA + (size_t)(t + 2) * kstep; const char* b2 = last ? nB : cB + (size_t)(t + 2) * kstep; \
            const char* a3 = a2 + kstep; const char* b3 = b2 + kstep; \
            const size_t hs2 = last ? nhsA : hsA; \
            PG8_LDB(B0, 0, 0); PG8_LDB(B1, 0, 1); PG8_SCHED; PG8_LDA(At, 0, 0); PG8_STAGE(PG8_SA(1, 1), a1 + hsA, voffA); \
            PG8_WAIT_V(8); PG8_WAIT_L(0); PG8_BAR; PG8_MMA(0, 0, At, B0); PG8_MMA(0, 1, At, B1); PG8_BAR; PG8_SCHED; \
            if (FULL) PG8_LDA(At, 0, 1); PG8_STAGE(PG8_SB(0, 0), b2, voffB); PG8_STAGE(PG8_SB(0, 1), b2 + hstep, voffB); PG8_STAGE(PG8_SA(0, 0), a2, voffA); \
            PG8_WAIT_V(8); PG8_WAIT_L(0); PG8_BAR; if (FULL) { PG8_MMA(1, 0, At, B0); PG8_MMA(1, 1, At, B1); } PG8_BAR; PG8_SCHED; \
            PG8_LDB(B0, 1, 0); PG8_LDB(B1, 1, 1); PG8_SCHED; PG8_LDA(At, 1, 0); PG8_STAGE(PG8_SA(0, 1), a2 + hs2, voffA); \
            PG8_WAIT_V(8); PG8_WAIT_L(0); PG8_BAR; PG8_MMA(0, 0, At, B0); PG8_MMA(0, 1, At, B1); PG8_BAR; PG8_SCHED; \
            if (FULL) PG8_LDA(At, 1, 1); PG8_STAGE(PG8_SB(1, 0), b3, voffB); PG8_STAGE(PG8_SB(1, 1), b3 + hstep, voffB); PG8_STAGE(PG8_SA(1, 0), a3, voffA); \
            PG8_WAIT_V(8); PG8_WAIT_L(0); PG8_BAR; if (FULL) { PG8_MMA(1, 0, At, B0); PG8_MMA(1, 1, At, B1); } PG8_BAR; PG8_SCHED; \
        }
        if (full_u) { PG8_KLOOP(true) } else { PG8_KLOOP(false) }
#undef PG8_KLOOP
        if (wr == 0) PG8_BAR;
        E(acc, cur, wr, wc, fr, fq, nxt, has_next, ui);
        if (!has_next) break;
#pragma unroll
        for (int a = 0; a < 2; ++a)
#pragma unroll
            for (int b = 0; b < 2; ++b)
#pragma unroll
                for (int m = 0; m < 4; ++m)
#pragma unroll
                    for (int n = 0; n < 2; ++n) acc[a][b][m][n] = (f32x4){0.f, 0.f, 0.f, 0.f};
        cur = nxt; cA = nA; cB = nB; hsA = nhsA; ++ui;
        if (wr == 1) PG8_BAR;
    }
    PG8_WAIT_V(0);
    PG8_BAR;
#undef PG8_SA
#undef PG8_SB
#undef PG8_STAGE
#undef PG8_LDA
#undef PG8_LDB
#undef PG8_MMA
#undef PG8_WAIT_V
#undef PG8_WAIT_L
#undef PG8_BAR
#undef PG8_SCHED
}
}

struct EpiInProj {
    bf16_t* P; const float* qw; const float* kw; float qscale;
    __device__ __forceinline__ void operator()(const f32x4 (&acc)[2][2][4][2], const pg8::Unit& u, int wr, int wc, int fr_in, int fq_in, const pg8::Unit&, bool, int) const {
        int fr = fr_in, fq = fq_in; asm volatile("" : "+v"(fr), "+v"(fq));
        const int nai = u.h < 0 ? 2 : 1, rowh = u.pm * 256 + (u.h > 0 ? 128 : 0);
        const int tile = u.pn;
        const bool isq = tile < 2, isk = (tile == 2) && (wc < 2);
        const bool nrm = isq || isk;
        f32x4 gw[2][2];
#pragma unroll
        for (int bj = 0; bj < 2; ++bj)
#pragma unroll
            for (int n = 0; n < 2; ++n) {
                const int d = 32 * bj + 8 * fq + 4 * n;
                f32x4 w = (f32x4){1.f, 1.f, 1.f, 1.f};
                if (isq) w = *(const f32x4*)(qw + d) * qscale; else if (isk) w = *(const f32x4*)(kw + d);
                gw[bj][n] = w;
            }
        if (tile >= 5) {
            const int colc = COL_CU + 128 * (tile - 5) + 32 * wc + 8 * fq;
#pragma unroll
            for (int ai = 0; ai < 2; ++ai)
#pragma unroll
                for (int m = 0; m < 4; ++m) {
                    if (ai >= nai) continue;
                    const int row = rowh + ai * 128 + wr * 64 + m * 16 + fr;
                    const f32x4 a = acc[ai][0][m][0] * acc[ai][1][m][0], b = acc[ai][0][m][1] * acc[ai][1][m][1];
                    u32x4 w; w.x = cvtpk(a[0], a[1]); w.y = cvtpk(a[2], a[3]); w.z = cvtpk(b[0], b[1]); w.w = cvtpk(b[2], b[3]);
                    *(u32x4*)(P + (size_t)row * PW + colc) = w;
                }
            return;
        }
        const int colb = 256 * tile + 64 * wc + 8 * fq;
#pragma unroll
        for (int ai = 0; ai < 2; ++ai)
#pragma unroll
            for (int m = 0; m < 4; ++m) {
                if (ai >= nai) continue;
                    const int row = rowh + ai * 128 + wr * 64 + m * 16 + fr;
                f32x4 v[2][2];
#pragma unroll
                for (int bj = 0; bj < 2; ++bj)
#pragma unroll
                    for (int n = 0; n < 2; ++n) v[bj][n] = acc[ai][bj][m][n];
                if (nrm) {
                    float ss = 0.f;
#pragma unroll
                    for (int bj = 0; bj < 2; ++bj)
#pragma unroll
                        for (int n = 0; n < 2; ++n) { const f32x4 x = v[bj][n]; ss += (x[0] * x[0] + x[1] * x[1]) + (x[2] * x[2] + x[3] * x[3]); }
                    ss += __shfl_xor(ss, 16); ss += __shfl_xor(ss, 32);
                    const float r = fast_rsqrt(ss * (1.0f / 64.0f) + EPS);
#pragma unroll
                    for (int bj = 0; bj < 2; ++bj)
#pragma unroll
                        for (int n = 0; n < 2; ++n) v[bj][n] = v[bj][n] * r * gw[bj][n];
                }
                bf16_t* rowp = P + (size_t)row * PW + colb;
#pragma unroll
                for (int bj = 0; bj < 2; ++bj) {
                    u32x4 w; w.x = cvtpk(v[bj][0][0], v[bj][0][1]); w.y = cvtpk(v[bj][0][2], v[bj][0][3]); w.z = cvtpk(v[bj][1][0], v[bj][1][1]); w.w = cvtpk(v[bj][1][2], v[bj][1][3]);
                    *(u32x4*)(rowp + 32 * bj) = w;
                }
            }
    }
};

struct EpiOutProj {
    const float* x; bf16_t* xn; float* part;
    __device__ __forceinline__ void operator()(const f32x4 (&acc)[2][2][4][2], const pg8::Unit& u, int wr, int wc, int fr_in, int fq_in, const pg8::Unit&, bool, int) const {
        int fr = fr_in, fq = fq_in; asm volatile("" : "+v"(fr), "+v"(fq));
        const int col0 = u.pn * 256 + wc * 32 + 8 * fq;
#pragma unroll
        for (int ai = 0; ai < 2; ++ai)
#pragma unroll
            for (int m = 0; m < 4; ++m) {
                const int row = u.pm * 256 + ai * 128 + wr * 64 + m * 16 + fr;
                const size_t off = (size_t)row * DM + col0;
                float ss = 0.f;
#pragma unroll
                for (int bj = 0; bj < 2; ++bj) {
                    const f32x4 x0 = __builtin_nontemporal_load((const f32x4*)(x + off + bj * 128)), x1 = __builtin_nontemporal_load((const f32x4*)(x + off + bj * 128 + 4));
                    const f32x4 a = x0 + acc[ai][bj][m][0], b = x1 + acc[ai][bj][m][1];
                    ss += (a[0] * a[0] + a[1] * a[1]) + (a[2] * a[2] + a[3] * a[3]) + (b[0] * b[0] + b[1] * b[1]) + (b[2] * b[2] + b[3] * b[3]);
                    u32x4 w; w.x = cvtpk(a[0], a[1]); w.y = cvtpk(a[2], a[3]); w.z = cvtpk(b[0], b[1]); w.w = cvtpk(b[2], b[3]);
                    *(u32x4*)(xn + off + bj * 128) = w;
                }
                ss += __shfl_xor(ss, 16); ss += __shfl_xor(ss, 32);
                if (fq == 0) part[(size_t)row * 16 + u.pn * 4 + wc] = ss;
            }
    }
};

struct EpiDown {
    const bf16_t* xn; float* out;
    __device__ __forceinline__ void operator()(const f32x4 (&acc)[2][2][4][2], const pg8::Unit& u, int wr, int wc, int fr_in, int fq_in, const pg8::Unit&, bool, int) const {
        int fr = fr_in, fq = fq_in; asm volatile("" : "+v"(fr), "+v"(fq));
        const int col0 = u.pn * 256 + wc * 32 + 8 * fq;
#pragma unroll
        for (int ai = 0; ai < 2; ++ai)
#pragma unroll
            for (int m = 0; m < 4; ++m) {
                const int row = u.pm * 256 + ai * 128 + wr * 64 + m * 16 + fr;
                const size_t off = (size_t)row * DM + col0;
#pragma unroll
                for (int bj = 0; bj < 2; ++bj) {
                    const u32x4 r = *(const u32x4*)(xn + off + bj * 128);
                    const f32x4 x0 = (f32x4){bflo(r.x), bfhi(r.x), bflo(r.y), bfhi(r.y)}, x1 = (f32x4){bflo(r.z), bfhi(r.z), bflo(r.w), bfhi(r.w)};
                    __builtin_nontemporal_store(x0 + acc[ai][bj][m][0], (f32x4*)(out + off + bj * 128)); __builtin_nontemporal_store(x1 + acc[ai][bj][m][1], (f32x4*)(out + off + bj * 128 + 4));
                }
            }
    }
};

__device__ __forceinline__ float dpp_shr1(float old, float src) { return __builtin_bit_cast(float, __builtin_amdgcn_update_dpp(__builtin_bit_cast(int, old), __builtin_bit_cast(int, src), 0x111, 0xf, 0xf, false)); }

struct EpiUpConv {
    bf16_t* act; const float* part; const float* cw; float* edge; LAS unsigned char* xch; mutable int rs_pm;
    __device__ __forceinline__ void operator()(f32x4 (&acc)[2][2][4][2], const pg8::Unit& u, int wr, int wc, int fr_in, int fq_in, const pg8::Unit& nxt, bool has_next, int ui) const {
        int fr = fr_in, fq = fq_in, tid = threadIdx.x;
        asm volatile("" : "+v"(fr), "+v"(fq), "+v"(tid));
        LAS f32x4* H = (LAS f32x4*)xch;
        LAS f32x4* CW = (LAS f32x4*)(xch + CWS_OFF) + (ui & 1) * 192;
        LAS f32x4* CWN = (LAS f32x4*)(xch + CWS_OFF) + ((ui + 1) & 1) * 192;
        LAS float* RS = (LAS float*)(xch + RS_OFF);
        const int nai = u.h < 0 ? 2 : 1, rbase = u.h > 0 ? 128 : 0;
        const int ctap = tid >> 6, cr = tid & 63;
        f32x4 cwv = (f32x4){0.f, 0.f, 0.f, 0.f}, cwn = (f32x4){0.f, 0.f, 0.f, 0.f};
        if (ui == 0 && tid < 192) cwv = *(const f32x4*)(cw + (size_t)ctap * NUP + (cr >> 5) * DFF + 128 * u.pn + 4 * (cr & 31));
        if (has_next && tid < 192) cwn = *(const f32x4*)(cw + (size_t)ctap * NUP + (cr >> 5) * DFF + 128 * nxt.pn + 4 * (cr & 31));
        if (u.pm != rs_pm) {
            if (tid < 256) {
                const float* pp = part + (size_t)(u.pm * 256 + tid) * 16;
                const f32x4 p0 = *(const f32x4*)pp, p1 = *(const f32x4*)(pp + 4), p2 = *(const f32x4*)(pp + 8), p3 = *(const f32x4*)(pp + 12);
                const float s = ((p0[0] + p0[1]) + (p0[2] + p0[3])) + ((p1[0] + p1[1]) + (p1[2] + p1[3])) + ((p2[0] + p2[1]) + (p2[2] + p2[3])) + ((p3[0] + p3[1]) + (p3[2] + p3[3]));
                RS[tid] = fast_rsqrt(s * (1.0f / (float)DM) + EPS);
            }
            asm volatile("s_waitcnt lgkmcnt(0)" ::: "memory"); __builtin_amdgcn_s_barrier(); asm volatile("" ::: "memory");
            rs_pm = u.pm;
        }
#pragma unroll
        for (int ai = 0; ai < 2; ++ai)
#pragma unroll
            for (int m = 0; m < 4; ++m) {
                if (ai >= nai) continue;
                const float rs = RS[rbase + ai * 128 + wr * 64 + 4 * fr + m];
#pragma unroll
                for (int bj = 0; bj < 2; ++bj)
#pragma unroll
                    for (int n = 0; n < 2; ++n) acc[ai][bj][m][n] = acc[ai][bj][m][n] * rs;
            }
        if (ui == 0 && tid < 192) CW[tid] = cwv;
        if (fr == 15) {
#pragma unroll
            for (int ai = 0; ai < 2; ++ai)
#pragma unroll
                for (int bj = 0; bj < 2; ++bj)
#pragma unroll
                    for (int n = 0; n < 2; ++n) {
                        H[((((ai * 2 + wr) * 4 + wc) * 2 + 0) * 4 + (bj * 2 + n)) * 4 + fq] = acc[ai][bj][2][n];
                        H[((((ai * 2 + wr) * 4 + wc) * 2 + 1) * 4 + (bj * 2 + n)) * 4 + fq] = acc[ai][bj][3][n];
                    }
        }
        const int colg = 128 * u.pn + 32 * wc + 8 * fq;
        if (wr == 0 && fr == 0) {
#pragma unroll
            for (int rsel = 0; rsel < 2; ++rsel) {
                float* e = edge + ((size_t)(u.pm * 8 + (u.h > 0 ? 6 : 0) + rsel)) * NUP + colg;
#pragma unroll
                for (int bj = 0; bj < 2; ++bj)
#pragma unroll
                    for (int n = 0; n < 2; ++n) *(f32x4*)(e + bj * DFF + 4 * n) = acc[0][bj][rsel][n];
            }
        }
        if (wr == 1 && fr == 15) {
#pragma unroll
            for (int rsel = 0; rsel < 2; ++rsel) {
                float* e = edge + ((size_t)(u.pm * 8 + (u.h == 0 ? 4 : 2) + rsel)) * NUP + colg;
#pragma unroll
                for (int bj = 0; bj < 2; ++bj)
#pragma unroll
                    for (int n = 0; n < 2; ++n) *(f32x4*)(e + bj * DFF + 4 * n) = (nai == 2) ? acc[1][bj][2 + rsel][n] : acc[0][bj][2 + rsel][n];
            }
        }
        asm volatile("s_waitcnt lgkmcnt(0)" ::: "memory"); __builtin_amdgcn_s_barrier(); asm volatile("" ::: "memory");
        const int cwi = 8 * wc + 2 * fq;
#pragma unroll
        for (int ai = 0; ai < 2; ++ai) {
            if (ai >= nai) continue;
            const int chunk = ai * 2 + wr;
            const int pch = chunk > 0 ? chunk - 1 : 0;
            u32x2 res[4][2];
#pragma unroll
            for (int n = 0; n < 2; ++n) {
                f32x4 y[2][4];
#pragma unroll
                for (int bj = 0; bj < 2; ++bj) {
                    const f32x4 w0 = CW[cwi + 32 * bj + n], w1 = CW[64 + cwi + 32 * bj + n], w2 = CW[128 + cwi + 32 * bj + n];
                    const f32x4 h62 = H[(((pch * 4 + wc) * 2 + 0) * 4 + (bj * 2 + n)) * 4 + fq], h63 = H[(((pch * 4 + wc) * 2 + 1) * 4 + (bj * 2 + n)) * 4 + fq];
                    const f32x4 x0 = acc[ai][bj][0][n], x1 = acc[ai][bj][1][n], x2 = acc[ai][bj][2][n], x3 = acc[ai][bj][3][n];
                    f32x4 p2, p3;
#pragma unroll
                    for (int j = 0; j < 4; ++j) { p2[j] = dpp_shr1(h62[j], x2[j]); p3[j] = dpp_shr1(h63[j], x3[j]); }
                    y[bj][0] = w2 * x0 + w1 * p3 + w0 * p2;
                    y[bj][1] = w2 * x1 + w1 * x0 + w0 * p3;
                    y[bj][2] = w2 * x2 + w1 * x1 + w0 * x0;
                    y[bj][3] = w2 * x3 + w1 * x2 + w0 * x1;
                }
#pragma unroll
                for (int m = 0; m < 4; ++m) {
                    const f32x4 g = y[0][m], v = y[1][m];
                    res[m][n].x = cvtpk(siluf(g[0]) * v[0], siluf(g[1]) * v[1]); res[m][n].y = cvtpk(siluf(g[2]) * v[2], siluf(g[3]) * v[3]);
                }
            }
#pragma unroll
            for (int m = 0; m < 4; ++m) {
                const int rt = ai * 128 + wr * 64 + 4 * fr + m;
                if (rt >= 2) { u32x4 w; w.x = res[m][0].x; w.y = res[m][0].y; w.z = res[m][1].x; w.w = res[m][1].y;
                    *(u32x4*)(act + (size_t)(u.pm * 256 + rbase + rt) * DFF + colg) = w; }
            }
        }
        if (has_next && tid < 192) CWN[tid] = cwn;
    }
};

__device__ __forceinline__ float wave_sum(float v) {
#pragma unroll
    for (int o = 1; o < 64; o <<= 1) v += __shfl_xor(v, o);
    return v;
}
template <int MODE>
__device__ __forceinline__ void p0_transpose_item(const float* W, int K, int N, bf16_t* WT, const float* gain, LAS float* scr, int item, int lane) {
    const int nblk = N / 32, kb = item / nblk, nb = item % nblk, k0 = 64 * kb, n0 = 32 * nb;
    int p0;
    if (MODE == 0) p0 = n0;
    else if (MODE == 1) {
        if (n0 < COL_C) { const int tile = n0 >> 8, c = n0 & 255, wc = c >> 6, bj = (c >> 5) & 1; p0 = tile * 256 + 128 * bj + 32 * wc; }
        else if (n0 < COL_U) { const int cc = n0 - COL_C; p0 = (5 + (cc >> 7)) * 256 + (cc & 127); }
        else { const int uc = n0 - COL_U; p0 = (5 + (uc >> 7)) * 256 + 128 + (uc & 127); }
    }
    else { if (n0 < DFF) p0 = 256 * (n0 >> 7) + (n0 & 127); else { const int n1 = n0 - DFF; p0 = 256 * (n1 >> 7) + 128 + (n1 & 127); } }
#pragma unroll 8
    for (int i = 0; i < 32; ++i) { const int kk = 2 * i + (lane >> 5); float v = W[(size_t)(k0 + kk) * N + n0 + (lane & 31)]; if (MODE == 2) v *= gain[k0 + kk]; scr[kk * 33 + (lane & 31)] = v; }
    asm volatile("s_waitcnt lgkmcnt(0)" ::: "memory");
    const int c = lane & 7;
#pragma unroll
    for (int j = 0; j < 4; ++j) { const int n = (lane >> 3) + 8 * j; const LAS float* s = scr + (8 * c) * 33 + n;
        u32x4 o; o.x = cvtpk(s[0 * 33], s[1 * 33]); o.y = cvtpk(s[2 * 33], s[3 * 33]); o.z = cvtpk(s[4 * 33], s[5 * 33]); o.w = cvtpk(s[6 * 33], s[7 * 33]);
        *(u32x4*)(WT + (size_t)(p0 + n) * K + k0 + 8 * c) = o; }
    asm volatile("s_waitcnt lgkmcnt(0)" ::: "memory");
}

namespace p2 {
constexpr int KPITCH = 72;
constexpr int KS_BYTES = 2 * 192 * KPITCH * 2;
constexpr int VT_OFF = KS_BYTES, VT_BYTES = 2 * 208 * KPITCH * 2;
constexpr int SS_OFF = VT_OFF + VT_BYTES;
static_assert(SS_OFF + 2048 <= RING_BYTES, "P2 LDS");
static_assert(XCH_OFF + RS_OFF + 1024 <= LDS_BYTES && MISC_OFF + 128 <= XCH_OFF + CWS_OFF, "exchange LDS map");
}

struct Args { const float* in[14]; float* out; unsigned char* ws; int cg_flag; int pad; };

__device__ __forceinline__ void p2_unit(LAS unsigned char* lds, const bf16_t* __restrict__ proj, bf16_t* __restrict__ mix, const float* __restrict__ sinks, const float* __restrict__ aw,
                                        const float* __restrict__ cmw, const float* __restrict__ cow, int unit, int tid, int lane, int wave) {
    using namespace p2;
    asm volatile("" : "+v"(tid), "+v"(lane));
    const int q0 = unit * 64;
    u32x4 kreg[6], vreg[6];
#pragma unroll
    for (int i = 0; i < 6; ++i) {
        const int id = i * 512 + tid, c = id & 7, rest = id >> 3, kv = rest / 192, kidx = rest - kv * 192, tok = q0 - 128 + kidx;
        kreg[i] = (u32x4){0u, 0u, 0u, 0u}; vreg[i] = (u32x4){0u, 0u, 0u, 0u};
        if (tok >= 0) { const bf16_t* src = proj + (size_t)tok * PW; kreg[i] = *(const u32x4*)(src + COL_K + 64 * kv + 8 * c); vreg[i] = *(const u32x4*)(src + COL_V + 64 * kv + 8 * c); }
    }
    __builtin_amdgcn_sched_barrier(0);
    const int c0 = 8 * lane, t0 = q0 + 8 * wave;
    u32x4 Cv[10], Bv[8];
#define P2_LOAD_CU(i) do { const int t_ = t0 - 2 + (i); Cv[i] = (u32x4){0u, 0u, 0u, 0u}; \
        if (t_ >= 0) Cv[i] = *(const u32x4*)(proj + (size_t)t_ * PW + c0 + COL_CU); } while (0)
#define P2_LOAD_B(i) do { Bv[i] = *(const u32x4*)(proj + (size_t)(t0 + (i)) * PW + c0 + COL_B); } while (0)
    P2_LOAD_CU(0); P2_LOAD_CU(1); P2_LOAD_CU(2); P2_LOAD_CU(3); P2_LOAD_CU(4); P2_LOAD_CU(5);
    P2_LOAD_B(0); P2_LOAD_B(1); P2_LOAD_B(2); P2_LOAD_B(3);
    float w0[8], w1[8], w2[8], gn[8];
#pragma unroll
    for (int hf = 0; hf < 2; ++hf) {
        const f32x4 a = *(const f32x4*)(cmw + c0 + 4 * hf), b = *(const f32x4*)(cmw + 512 + c0 + 4 * hf), c = *(const f32x4*)(cmw + 1024 + c0 + 4 * hf), d = *(const f32x4*)(cow + c0 + 4 * hf);
#pragma unroll
        for (int e = 0; e < 4; ++e) { w0[4 * hf + e] = a[e]; w1[4 * hf + e] = b[e]; w2[4 * hf + e] = c[e]; gn[4 * hf + e] = d[e]; }
    }
    __builtin_amdgcn_sched_barrier(0);
#pragma unroll
    for (int i = 0; i < 6; ++i) {
        const int id = i * 512 + tid, c = id & 7, rest = id >> 3, kv = rest / 192, kidx = rest - kv * 192;
        *(LAS u32x4*)(lds + ((kv * 192 + kidx) * KPITCH + 8 * c) * 2) = kreg[i];
        *(LAS u32x4*)(lds + VT_OFF + ((kv * 208 + kidx) * KPITCH + 8 * c) * 2) = vreg[i];
    }
    if (tid < 256) { const int kv = tid >> 7, r = (tid >> 3) & 15, c = tid & 7; *(LAS u32x4*)(lds + VT_OFF + ((kv * 208 + 192 + r) * KPITCH + 8 * c) * 2) = (u32x4){0u, 0u, 0u, 0u}; }
    __builtin_amdgcn_sched_barrier(0);
    P2_LOAD_CU(6); P2_LOAD_CU(7); P2_LOAD_CU(8); P2_LOAD_CU(9);
    P2_LOAD_B(4); P2_LOAD_B(5); P2_LOAD_B(6); P2_LOAD_B(7);
    __builtin_amdgcn_sched_barrier(0);
    float cm2[8], cm1[8];
#define P2_CONV_STEP(i) do { const u32x4 C = Cv[i]; float cu[8]; \
        cu[0] = bflo(C.x); cu[1] = bfhi(C.x); cu[2] = bflo(C.y); cu[3] = bfhi(C.y); cu[4] = bflo(C.z); cu[5] = bfhi(C.z); cu[6] = bflo(C.w); cu[7] = bfhi(C.w); \
        if ((i) >= 2) { const u32x4 B = Bv[(i) >= 2 ? (i) - 2 : 0]; \
            const float bb[8] = {bflo(B.x), bfhi(B.x), bflo(B.y), bfhi(B.y), bflo(B.z), bfhi(B.z), bflo(B.w), bfhi(B.w)}; \
            float cv[8]; float ss = 0.f; \
            _Pragma("unroll") for (int e = 0; e < 8; ++e) { const float y = w0[e] * cm2[e] + w1[e] * cm1[e] + w2[e] * cu[e]; cv[e] = bb[e] * y; ss += cv[e] * cv[e]; } \
            ss = wave_sum(ss); \
            const float r = fast_rsqrt(ss * (1.0f / 512.0f) + EPS); \
            u32x4 w; w.x = cvtpk(cv[0] * r * gn[0], cv[1] * r * gn[1]); w.y = cvtpk(cv[2] * r * gn[2], cv[3] * r * gn[3]); \
            w.z = cvtpk(cv[4] * r * gn[4], cv[5] * r * gn[5]); w.w = cvtpk(cv[6] * r * gn[6], cv[7] * r * gn[7]); \
            *(u32x4*)(mix + (size_t)(t0 + (i) - 2) * DM + 512 + c0) = w; } \
        _Pragma("unroll") for (int e = 0; e < 8; ++e) { cm2[e] = ((i) == 0) ? 0.f : cm1[e]; cm1[e] = cu[e]; } } while (0)
    P2_CONV_STEP(0); P2_CONV_STEP(1); P2_CONV_STEP(2); P2_CONV_STEP(3); P2_CONV_STEP(4); P2_CONV_STEP(5);
    __builtin_amdgcn_sched_barrier(0);
    const int h = wave, kvh = h >> 2, fr = lane & 15, fq = lane >> 4;
    bf16x8 Qf[4][2];
#pragma unroll
    for (int qt = 0; qt < 4; ++qt) {
        const bf16_t* qp = proj + (size_t)(q0 + 16 * qt + fr) * PW + 64 * h + 8 * fq;
        Qf[qt][0] = *(const bf16x8*)qp; Qf[qt][1] = *(const bf16x8*)(qp + 32);
    }
    const float sink2 = sinks[h] * LOG2E;
    __builtin_amdgcn_sched_barrier(0);
    P2_CONV_STEP(6); P2_CONV_STEP(7); P2_CONV_STEP(8); P2_CONV_STEP(9);
#undef P2_LOAD_CU
#undef P2_LOAD_B
#undef P2_CONV_STEP
    __syncthreads();
    LAS float* SSf = (LAS float*)(lds + SS_OFF);
    const bool early = q0 < 128;
    f32x4 O[4][4];
#pragma unroll
    for (int qt = 0; qt < 4; ++qt) {
        const bf16x8 Q0 = Qf[qt][0], Q1 = Qf[qt][1];
        f32x4 S[9];
#pragma unroll
        for (int kt = 0; kt < 9; ++kt) {
            const LAS unsigned char* kp = lds + ((kvh * 192 + 16 * (qt + kt) + fr) * KPITCH + 8 * fq) * 2;
            const bf16x8 K0 = *(const LAS bf16x8*)kp, K1 = *(const LAS bf16x8*)(kp + 64);
            f32x4 a = (f32x4){0.f, 0.f, 0.f, 0.f};
            a = __builtin_amdgcn_mfma_f32_16x16x32_bf16(K0, Q0, a, 0, 0, 0);
            a = __builtin_amdgcn_mfma_f32_16x16x32_bf16(K1, Q1, a, 0, 0, 0);
            S[kt] = a;
        }
        float mx = sink2;
#pragma unroll
        for (int kt = 0; kt < 9; ++kt)
#pragma unroll
            for (int j = 0; j < 4; ++j) {
                const int jt = q0 - 128 + 16 * (qt + kt) + 4 * fq + j;
                bool valid = early ? (jt >= 0) : true;
                if (kt == 0) valid = valid && (fr < 4 * fq + j);
                if (kt == 8) valid = valid && (fr >= 4 * fq + j);
                const float sv = valid ? S[kt][j] : -1e30f;
                S[kt][j] = sv; mx = fmaxf(mx, sv);
            }
        mx = fmaxf(mx, __shfl_xor(mx, 16)); mx = fmaxf(mx, __shfl_xor(mx, 32));
        float l = 0.f;
#pragma unroll
        for (int kt = 0; kt < 9; ++kt)
#pragma unroll
            for (int j = 0; j < 4; ++j) { const float p = __builtin_amdgcn_exp2f(S[kt][j] - mx); S[kt][j] = p; l += p; }
        l += __shfl_xor(l, 16); l += __shfl_xor(l, 32);
        l += __builtin_amdgcn_exp2f(sink2 - mx);
        const float inv = __builtin_amdgcn_rcpf(l);
        bf16x8 pb[5];
#pragma unroll
        for (int s2 = 0; s2 < 5; ++s2) {
            u32x4 w; w.x = cvtpk(S[2 * s2][0], S[2 * s2][1]); w.y = cvtpk(S[2 * s2][2], S[2 * s2][3]);
            if (2 * s2 + 1 < 9) { w.z = cvtpk(S[2 * s2 + 1 < 9 ? 2 * s2 + 1 : 0][0], S[2 * s2 + 1 < 9 ? 2 * s2 + 1 : 0][1]); w.w = cvtpk(S[2 * s2 + 1 < 9 ? 2 * s2 + 1 : 0][2], S[2 * s2 + 1 < 9 ? 2 * s2 + 1 : 0][3]); }
            else { w.z = 0u; w.w = 0u; }
            pb[s2] = __builtin_bit_cast(bf16x8, w);
        }
#pragma unroll
        for (int dt = 0; dt < 4; ++dt) {
            f32x4 o = (f32x4){0.f, 0.f, 0.f, 0.f};
#pragma unroll
            for (int s2 = 0; s2 < 5; ++s2) {
                const LAS unsigned char* vp = lds + VT_OFF + ((kvh * 208 + 16 * (qt + 2 * s2) + 4 * fq + (fr >> 2)) * KPITCH + 16 * dt + 4 * (fr & 3)) * 2;
                const s16x4 lo = __builtin_amdgcn_ds_read_tr16_b64_v4i16((LAS s16x4*)vp), hi = __builtin_amdgcn_ds_read_tr16_b64_v4i16((LAS s16x4*)(vp + 16 * KPITCH * 2));
                const bf16x8 vfb = (bf16x8){lo[0], lo[1], lo[2], lo[3], hi[0], hi[1], hi[2], hi[3]};
                o = __builtin_amdgcn_mfma_f32_16x16x32_bf16(vfb, pb[s2], o, 0, 0, 0);
            }
            O[qt][dt] = o * inv;
        }
        float ss = 0.f;
#pragma unroll
        for (int dt = 0; dt < 4; ++dt) { const f32x4 o = O[qt][dt]; ss += (o[0] * o[0] + o[1] * o[1]) + (o[2] * o[2] + o[3] * o[3]); }
        ss += __shfl_xor(ss, 16); ss += __shfl_xor(ss, 32);
        if (fq == 0) SSf[h * 64 + 16 * qt + fr] = ss;
    }
    __syncthreads();
#pragma unroll
    for (int qt = 0; qt < 4; ++qt) {
        float tot = 0.f;
#pragma unroll
        for (int hh = 0; hh < 8; ++hh) tot += SSf[hh * 64 + 16 * qt + fr];
        const float r = fast_rsqrt(tot * (1.0f / 512.0f) + EPS);
        bf16_t* mp = mix + (size_t)(q0 + 16 * qt + fr) * DM + 64 * h + 4 * fq;
#pragma unroll
        for (int dt = 0; dt < 4; ++dt) {
            const f32x4 g = *(const f32x4*)(aw + 64 * h + 16 * dt + 4 * fq);
            const f32x4 v = O[qt][dt] * r * g;
            u32x2 w; w.x = cvtpk(v[0], v[1]); w.y = cvtpk(v[2], v[3]);
            *(u32x2*)(mp + 16 * dt) = w;
        }
    }
    __syncthreads();
}

#define XB_TMO      128
#define XB_XCNT(j)  (256  + 64 * (j))
#define XB_XSUB(j)  (1280 + 64 * (j))
#define XB_XGEN(j)  (2304 + 64 * (j))
#define XB_TOP      3328
#define XB_TOPGEN   3392
#define XCD_BAR_WORDS 3456
#define XB_SPIN_CAP (1u << 18)
__device__ __forceinline__ unsigned xb_ld(unsigned* p)              { return __hip_atomic_load(p, __ATOMIC_RELAXED, __HIP_MEMORY_SCOPE_AGENT); }
__device__ __forceinline__ unsigned xb_add(unsigned* p, unsigned v) { return __hip_atomic_fetch_add(p, v, __ATOMIC_RELAXED, __HIP_MEMORY_SCOPE_AGENT); }
__device__ __forceinline__ unsigned xb_xcc_id() { return (unsigned)__builtin_amdgcn_s_getreg((3 << 11) | 20) & 0xFu; }
#define XB_SPIN(cond, bar) do { unsigned _sp = 0; while (cond) { __builtin_amdgcn_s_sleep(1); \
    if ((++_sp & 255u) == 0u) { if (xb_ld(&(bar)[XB_TMO])) break; if (_sp > XB_SPIN_CAP) { atomicAdd(&(bar)[XB_TMO], 1u); break; } } } } while (0)
struct XcdBarrier { unsigned* bar; unsigned x; volatile LAS unsigned* st; };
__device__ __forceinline__ XcdBarrier xcd_barrier_post(unsigned* bar, volatile LAS unsigned* st) {
    XcdBarrier b; b.bar = bar; b.x = xb_xcc_id(); b.st = st;
    if (threadIdx.x == 0) (void)xb_add(&bar[XB_XCNT(b.x)], 1u);
    return b;
}
__device__ __forceinline__ void xcd_barrier_complete(unsigned* bar, unsigned x, unsigned& nloc, unsigned& nx) {
    const unsigned G = gridDim.x * gridDim.y * gridDim.z;
    unsigned sum, cnt, mine, sp = 0u;
    for (;;) {
        sum = 0u; cnt = 0u; mine = 0u;
#pragma unroll
        for (unsigned j = 0; j < 16; ++j) { const unsigned c = xb_ld(&bar[XB_XCNT(j)]); sum += c; cnt += (c > 0u) ? 1u : 0u; mine = (j == x) ? c : mine; }
        if (sum == G) break;
        __builtin_amdgcn_s_sleep(1);
        if ((++sp & 255u) == 0u) { if (xb_ld(&bar[XB_TMO])) break; if (sp > XB_SPIN_CAP) { atomicAdd(&bar[XB_TMO], 1u); break; } }
    }
    nloc = mine > 0u ? mine : 1u; nx = cnt > 0u ? cnt : 1u;
}
__device__ __forceinline__ void xcd_barrier(const XcdBarrier& b) {
    asm volatile("s_waitcnt vmcnt(0)" ::: "memory");
    __syncthreads();
    if (threadIdx.x == 0) {
        unsigned* bar = b.bar;
        __builtin_amdgcn_s_waitcnt(0);
        unsigned nloc = b.st[0], nx = b.st[1];
        if (nloc == 0u) { xcd_barrier_complete(bar, b.x, nloc, nx); b.st[0] = nloc; b.st[1] = nx; }
        const unsigned old = xb_add(&bar[XB_XSUB(b.x)], 1u);
        const unsigned gen = old / nloc;
        if (old + 1u == (gen + 1u) * nloc) {
            __builtin_amdgcn_fence(__ATOMIC_RELEASE, "agent");
            asm volatile("s_waitcnt vmcnt(0)" ::: "memory");
            const unsigned og = xb_add(&bar[XB_TOP], 1u);
            const unsigned tg = og / nx;
            if (og + 1u == (tg + 1u) * nx) xb_add(&bar[XB_TOPGEN], 1u);
            else XB_SPIN(xb_ld(&bar[XB_TOPGEN]) == tg, bar);
            __builtin_amdgcn_fence(__ATOMIC_ACQUIRE, "agent");
            xb_add(&bar[XB_XGEN(b.x)], 1u);
            asm volatile("s_waitcnt vmcnt(0)" ::: "memory");
        } else {
            XB_SPIN(xb_ld(&bar[XB_XGEN(b.x)]) == gen, bar);
            __builtin_amdgcn_fence(__ATOMIC_ACQUIRE, "agent");
            asm volatile("s_waitcnt vmcnt(0)" ::: "memory");
        }
    }
    __syncthreads();
}

__device__ __forceinline__ void fix_rows(bf16_t* dst, const float* cw, const float* et, const float* e1, const float* e2, int f0) {
    float yv[2][8];
#pragma unroll
    for (int bj = 0; bj < 2; ++bj)
#pragma unroll
        for (int hf = 0; hf < 2; ++hf) {
            const int col = bj * DFF + f0 + 4 * hf;
            const f32x4 w0 = *(const f32x4*)(cw + col), w1 = *(const f32x4*)(cw + NUP + col), w2 = *(const f32x4*)(cw + 2 * NUP + col);
            const f32x4 z = (f32x4){0.f, 0.f, 0.f, 0.f};
            const f32x4 xt = *(const f32x4*)(et + col), x1 = e1 ? *(const f32x4*)(e1 + col) : z, x2 = e2 ? *(const f32x4*)(e2 + col) : z;
            const f32x4 y = w0 * x2 + w1 * x1 + w2 * xt;
#pragma unroll
            for (int e = 0; e < 4; ++e) yv[bj][4 * hf + e] = y[e];
        }
    u32x4 w; w.x = cvtpk(siluf(yv[0][0]) * yv[1][0], siluf(yv[0][1]) * yv[1][1]); w.y = cvtpk(siluf(yv[0][2]) * yv[1][2], siluf(yv[0][3]) * yv[1][3]);
    w.z = cvtpk(siluf(yv[0][4]) * yv[1][4], siluf(yv[0][5]) * yv[1][5]); w.w = cvtpk(siluf(yv[0][6]) * yv[1][6], siluf(yv[0][7]) * yv[1][7]);
    *(u32x4*)dst = w;
}

__device__ __forceinline__ void convert_w_in(const Args& a, bf16_t* Win_t, LAS float* scr, int gw, int NGW, int lane) {
    constexpr int I_IN = (DM / 64) * (NIN / 32);
    for (int it = gw; it < I_IN; it += NGW) p0_transpose_item<1>(a.in[2], DM, NIN, Win_t, nullptr, scr, it, lane);
}
__device__ __forceinline__ void convert_w_out_up(const Args& a, bf16_t* Wout_t, bf16_t* Wup_t, LAS float* scr, int gw, int NGW, int lane) {
    constexpr int I_OUT = (DM / 64) * (DM / 32), I_UP = (DM / 64) * (NUP / 32);
    for (int it = gw; it < I_OUT + I_UP; it += NGW) {
        if (it < I_OUT) p0_transpose_item<0>(a.in[9], DM, DM, Wout_t, nullptr, scr, it, lane);
        else p0_transpose_item<2>(a.in[11], DM, NUP, Wup_t, a.in[10], scr, it - I_OUT, lane);
    }
}
__device__ __forceinline__ void convert_w_down(const Args& a, bf16_t* Wdn_t, LAS float* scr, int gw, int NGW, int lane) {
    constexpr int I_DN = (DFF / 64) * (DM / 32);
    for (int it = gw; it < I_DN; it += NGW) p0_transpose_item<0>(a.in[13], DFF, DM, Wdn_t, nullptr, scr, it, lane);
}

__global__ void __launch_bounds__(512, 2) fwd_megakernel(Args a) {
    extern __shared__ __attribute__((aligned(16))) unsigned char lds_raw[];
    LAS unsigned char* lds = (LAS unsigned char*)lds_raw;
    cg::grid_group grid = cg::this_grid();
    const int tid = threadIdx.x, lane = tid & 63, wave = __builtin_amdgcn_readfirstlane(tid >> 6);
    const int G = gridDim.x, bx = blockIdx.x;
    unsigned char* ws = a.ws;
    volatile LAS unsigned* MISC = (volatile LAS unsigned*)(lds + MISC_OFF);
    if (tid < 32) MISC[tid] = 0u;
    __syncthreads();
    const XcdBarrier bar = xcd_barrier_post((unsigned*)(ws + WS_CTL), MISC + 8);
    if (a.cg_flag) grid.sync();
#define GRID_BAR() xcd_barrier(bar)
    const float* x = a.in[0]; float* out = a.out;
    bf16_t* Win_t = (bf16_t*)(ws + WS_WIN); bf16_t* Wout_t = (bf16_t*)(ws + WS_WOUT); bf16_t* Wup_t = (bf16_t*)(ws + WS_WUP); bf16_t* Wdn_t = (bf16_t*)(ws + WS_WDN);
    float* part = (float*)(ws + WS_PART); float* edge = (float*)(ws + WS_EDGE);
    bf16_t* XN = (bf16_t*)(ws + WS_XN); bf16_t* proj = (bf16_t*)(ws + WS_PROJ); bf16_t* mix = (bf16_t*)(ws + WS_MIX); bf16_t* act = (bf16_t*)(ws + WS_ACT);
    LAS float* scr = (LAS float*)(lds + wave * 16384);

    {
        const int gw = bx * 8 + wave, NGW = G * 8;
        convert_w_in(a, Win_t, scr, gw, NGW, lane);
        const float* gw1 = a.in[1];
        f32x4 gv[4];
#pragma unroll
        for (int j = 0; j < 4; ++j) gv[j] = *(const f32x4*)(gw1 + 4 * lane + 256 * j);
        for (int m = gw; m < SEQ; m += 4 * NGW) {
            f32x4 v[4][4];
#pragma unroll
            for (int rr = 0; rr < 4; ++rr) {
                const int mr = m + rr * NGW;
                const f32x4* xr = (const f32x4*)(x + (size_t)(mr < SEQ ? mr : m) * DM) + lane;
#pragma unroll
                for (int j = 0; j < 4; ++j) v[rr][j] = xr[64 * j];
            }
#pragma unroll
            for (int rr = 0; rr < 4; ++rr) {
                const int mr = m + rr * NGW;
                float s = 0.f;
#pragma unroll
                for (int j = 0; j < 4; ++j) s += (v[rr][j][0] * v[rr][j][0] + v[rr][j][1] * v[rr][j][1]) + (v[rr][j][2] * v[rr][j][2] + v[rr][j][3] * v[rr][j][3]);
                const float r = fast_rsqrt(wave_sum(s) * (1.0f / DM) + EPS);
                if (mr < SEQ) {
                    unsigned long long* o8 = (unsigned long long*)(XN + (size_t)mr * DM) + lane;
#pragma unroll
                    for (int j = 0; j < 4; ++j) { const f32x4 y = v[rr][j] * r * gv[j]; o8[64 * j] = (unsigned long long)cvtpk(y[0], y[1]) | ((unsigned long long)cvtpk(y[2], y[3]) << 32); }
                }
            }
        }
    }
    GRID_BAR();

    {
        pg8::Gemm g{XN, Win_t, SEQ, NIN, DM}; pg8::TailSplitOrder S; S.init(SEQ, NIN, G, bx);
        EpiInProj E{proj, a.in[3], a.in[4], 0.125f * LOG2E};
        pg8::gemm_phase<false, true>(lds, g, S, E);
        const int rem = (2 * S.rem > G) ? S.rem : 2 * S.rem;
        if (rem == 0) convert_w_out_up(a, Wout_t, Wup_t, scr, bx * 8 + wave, G * 8, lane);
        else if (bx >= rem) convert_w_out_up(a, Wout_t, Wup_t, scr, (bx - rem) * 8 + wave, (G - rem) * 8, lane);
    }
    GRID_BAR();

    {
        constexpr int NU = SEQ / 64, NPER = NU / 8;
        const bool xa = (G & 7) == 0;
        const int base = xa ? (bx & 7) * NPER : 0, j0 = xa ? (bx >> 3) : bx, js = xa ? (G >> 3) : G, jn = xa ? NPER : NU;
        for (int j = j0; j < jn; j += js) p2_unit(lds, proj, mix, a.in[5], a.in[7], a.in[6], a.in[8], base + j, tid, lane, wave);
    }
    GRID_BAR();

    {
        pg8::Gemm g{mix, Wout_t, SEQ, DM, DM}; pg8::StaticOrder S; S.init(SEQ, DM, G, bx);
        EpiOutProj E{x, XN, part};
        pg8::gemm_phase(lds, g, S, E);
    }
    GRID_BAR();

    {
        pg8::Gemm g{XN, Wup_t, SEQ, NUP, DM}; pg8::StaticOrder S; S.init(SEQ, NUP, G, bx);
        EpiUpConv E{act, part, a.in[12], edge, lds + XCH_OFF, -1};
        pg8::gemm_phase<true, false>(lds, g, S, E);
        const int rem = S.nwg % G;
        if (rem == 0) convert_w_down(a, Wdn_t, scr, bx * 8 + wave, G * 8, lane);
        else if (bx >= rem) convert_w_down(a, Wdn_t, scr, (bx - rem) * 8 + wave, (G - rem) * 8, lane);
    }
    GRID_BAR();

    {
        pg8::Gemm g{act, Wdn_t, SEQ, DM, DFF}; pg8::StaticOrder S; S.init(SEQ, DM, G, bx);
        const float* cw = a.in[12];
        constexpr int NCG = DFF / 8;
        pg8::TailSplitOrder S4; S4.init(SEQ, NUP, G, bx);
        const bool split4 = false;
        pg8::Unit fu;
        for (int i = 0; S.next(i, fu); ++i) {
            const int pm = fu.pm;
            for (int id = tid; id < 2 * NCG; id += 512) {
                const int rs = id / NCG, f0 = 8 * (id - rs * NCG);
                const float* et = edge + (size_t)(pm * 8 + rs) * NUP;
                const float* e1 = rs == 0 ? (pm > 0 ? edge + (size_t)((pm - 1) * 8 + 3) * NUP : nullptr) : edge + (size_t)(pm * 8 + 0) * NUP;
                const float* e2 = pm > 0 ? edge + (size_t)((pm - 1) * 8 + (rs == 0 ? 2 : 3)) * NUP : nullptr;
                fix_rows(act + (size_t)(pm * 256 + rs) * DFF + f0, cw, et, e1, e2, f0);
            }
            if (split4) {
                for (int pn4 = 0; pn4 < S4.b.nN; ++pn4) {
                    const int L = S4.b.index_of(pm, pn4);
                    if (L < S4.full * G) continue;
                    if (tid < 32) {
                        const int rs = tid >> 4, f0 = 128 * pn4 + 8 * (tid & 15);
                        const float* et = edge + (size_t)(pm * 8 + 6 + rs) * NUP;
                        const float* e1 = edge + (size_t)(pm * 8 + (rs == 0 ? 5 : 6)) * NUP;
                        const float* e2 = edge + (size_t)(pm * 8 + (rs == 0 ? 4 : 5)) * NUP;
                        fix_rows(act + (size_t)(pm * 256 + 128 + rs) * DFF + f0, cw, et, e1, e2, f0);
                    }
                }
            }
        }
        asm volatile("s_waitcnt vmcnt(0)" ::: "memory");
        __syncthreads();
        EpiDown E{XN, out};
        pg8::gemm_phase(lds, g, S, E);
    }
}

extern "C" void kernel_launch(void* const* d_in, const int* in_sizes, int n_in, void* d_out, int out_size, void* d_ws, size_t ws_size, hipStream_t stream) {
    static int grid_blocks = 0;
    if (grid_blocks == 0) {
        if (n_in != 14 || in_sizes[0] != SEQ * DM || out_size != SEQ * DM || ws_size < WS_END) { fprintf(stderr, "kernel_launch: unexpected shapes (n_in %d, ws %zu)\n", n_in, ws_size); grid_blocks = -1; return; }
        int dev = 0, cus = 0, per_cu = 0;
        hipGetDevice(&dev);
        hipDeviceGetAttribute(&cus, hipDeviceAttributeMultiprocessorCount, dev);
        if (hipFuncSetAttribute((const void*)fwd_megakernel, hipFuncAttributeMaxDynamicSharedMemorySize, LDS_BYTES) != hipSuccess) { fprintf(stderr, "kernel_launch: hipFuncSetAttribute failed\n"); grid_blocks = -1; return; }
        hipOccupancyMaxActiveBlocksPerMultiprocessor(&per_cu, (const void*)fwd_megakernel, 512, LDS_BYTES);
        if (per_cu < 1) per_cu = 1;
        grid_blocks = cus * 1;
        (void)per_cu; (void)hipGetLastError();
    }
    if (grid_blocks < 0) return;
    Args a{};
    for (int i = 0; i < 14; ++i) a.in[i] = (const float*)d_in[i];
    a.out = (float*)d_out; a.ws = (unsigned char*)d_ws;
    if (hipMemsetAsync((char*)d_ws + WS_CTL, 0, CTL_ZERO_BYTES, stream) != hipSuccess) { fprintf(stderr, "kernel_launch: memset failed\n"); return; }
    void* args[] = {&a};
    hipError_t e = hipLaunchCooperativeKernel((const void*)fwd_megakernel, dim3(grid_blocks), dim3(512), args, LDS_BYTES, stream);
    if (e != hipSuccess) fprintf(stderr, "cooperative launch failed: %s (grid %d)\n", hipGetErrorString(e), grid_blocks);
}
```

```cpp
#include <hip/hip_runtime.h>
#include <hip/hip_cooperative_groups.h>
#include <cstdio>
#include <cstdint>
namespace cg = cooperative_groups;

#define LAS __attribute__((address_space(3)))
typedef unsigned short bf16_t;
typedef short bf16x8 __attribute__((ext_vector_type(8)));
typedef float f32x4 __attribute__((ext_vector_type(4)));
typedef unsigned u32x4 __attribute__((ext_vector_type(4)));
typedef unsigned u32x2 __attribute__((ext_vector_type(2)));
typedef short s16x4 __attribute__((ext_vector_type(4)));

constexpr int SEQ = 16384, DM = 1024, NIN = 2304, DFF = 2816, NUP = 2 * DFF;
constexpr float EPS = 1e-6f;
constexpr float LOG2E = 1.4426950408889634f;
constexpr int COL_K = 512, COL_V = 640, COL_B = 768, COL_C = 1280, COL_U = 1792;
constexpr int PW = 1792, COL_CU = 1280;

constexpr size_t MiB = 1u << 20;
constexpr size_t WS_CTL = 0, CTL_ZERO_BYTES = 65536;
constexpr size_t WS_WIN = 1 * MiB;
constexpr size_t WS_WOUT = 6 * MiB;
constexpr size_t WS_WUP = 8 * MiB;
constexpr size_t WS_WDN = 20 * MiB;
constexpr size_t WS_PART = 26 * MiB;
constexpr size_t WS_EDGE = 170 * MiB;
constexpr size_t WS_XN = 34 * MiB;
constexpr size_t WS_PROJ = 66 * MiB;
constexpr size_t WS_MIX = 138 * MiB;
constexpr size_t WS_ACT = 66 * MiB;
constexpr size_t WS_END = 182 * MiB;

constexpr int RING_BYTES = 131072;
constexpr int XCH_OFF = RING_BYTES;
constexpr int CWS_OFF = 8192 + 256;
constexpr int RS_OFF = 8192 + 256 + 2 * 3072;
constexpr int MISC_OFF = XCH_OFF + 8192;
constexpr int LDS_BYTES = 147456;

typedef float f32x2_t __attribute__((ext_vector_type(2))); typedef __bf16 bf16x2_t __attribute__((ext_vector_type(2)));
__device__ __forceinline__ unsigned cvtpk(float lo, float hi) { f32x2_t v = {lo, hi}; bf16x2_t b = __builtin_convertvector(v, bf16x2_t); return __builtin_bit_cast(unsigned, b); }
__device__ __forceinline__ float bflo(unsigned u) { return __builtin_bit_cast(float, u << 16); }
__device__ __forceinline__ float bfhi(unsigned u) { return __builtin_bit_cast(float, u & 0xffff0000u); }
__device__ __forceinline__ float fast_rsqrt(float x) { return __builtin_amdgcn_rsqf(x); }
__device__ __forceinline__ float siluf(float g) { return g * __builtin_amdgcn_rcpf(1.0f + __builtin_amdgcn_exp2f(-g * LOG2E)); }

namespace pg8 {
constexpr int BM = 256, BK = 64, HALF = 128, HTB = HALF * BK * 2, STAGE_BYTES = 8 * HTB, NXCD = 8, WGM = 8;
__host__ __device__ __forceinline__ int lds_byte(int r, int c) { const int st = (r >> 4) * 2 + (c >> 5), rr = r & 15, cc = c & 31, ob = rr * 64 + cc * 2; return st * 1024 + (ob ^ (((ob >> 9) & 1) << 5)); }
__host__ __device__ __forceinline__ void stage_rc(int b, int& R, int& C) { const int st = b / 1024, sb = b % 1024, swz = sb ^ (((sb >> 9) & 1) << 5); R = (st >> 1) * 16 + swz / 64; C = (st & 1) * 32 + (swz % 64) / 2; }
__host__ __device__ __forceinline__ int perm32(int rho) { const int n = rho >> 4, i = rho & 15; return 8 * (i >> 2) + 4 * n + (i & 3); }

struct Unit { int pm, pn, h; };
struct Gemm { const bf16_t* A; const bf16_t* Bt; int M, N, K; };

struct StaticOrder {
    int nM, nN, nwg, G, c;
    __host__ __device__ void init(int M, int N, int G_, int c_) { nM = M / BM; nN = N / BM; nwg = nM * nN; G = G_; c = c_; }
    __host__ __device__ bool next(int i, Unit& u) const {
        const long L = (long)i * G + c; if (L >= nwg) return false;
        int wgid = (int)L; { const int q = nwg / NXCD, r = nwg % NXCD, xcd = wgid % NXCD, off = wgid / NXCD; wgid = (xcd < r ? xcd * (q + 1) : r * (q + 1) + (xcd - r) * q) + off; }
        const int nig = WGM * nN, gid = wgid / nig, fm = gid * WGM, gsz = (nM - fm) < WGM ? (nM - fm) : WGM;
        u.pm = fm + ((wgid % nig) % gsz); u.pn = (wgid % nig) / gsz; u.h = -1; return true;
    }
    __host__ __device__ int index_of(int pm, int pn) const {
        if (nwg % NXCD != 0) return -1;
        const int nig = WGM * nN, gid = pm / WGM, fm = gid * WGM, gsz = (nM - fm) < WGM ? (nM - fm) : WGM;
        const int wgid = gid * nig + pn * gsz + (pm - fm), q = nwg / NXCD;
        return (wgid % q) * NXCD + wgid / q;
    }
};
struct TailSplitOrder {
    StaticOrder b; int full, rem;
    __host__ __device__ void init(int M, int N, int G_, int c_) { b.init(M, N, G_, c_); full = b.nwg / G_; rem = b.nwg % G_; }
    __host__ __device__ bool team_form() const { return b.nwg % NXCD == 0 && b.nM == NXCD * WGM && b.G == 256 && rem != 0 && 2 * rem <= b.G && (full * (b.G / NXCD)) % WGM == 0; }
    __host__ __device__ bool next(int i, Unit& u) const {
        if (i < full || 2 * rem > b.G) return b.next(i, u);
        if (i > full) return false;
        if (team_form()) {
            const int x = b.c % NXCD, a = b.c / NXCD, p = a % WGM, s = a / WGM, q = b.nwg / NXCD, w0 = full * (b.G / NXCD), ntp = (q - w0) / WGM;
            if (s >= 2 * ntp) return false;
            const int w = w0 + WGM * (s >> 1) + p;
            u.pm = x * WGM + p; u.pn = w / WGM; u.h = s & 1; return true;
        }
        if (b.c >= 2 * rem) return false;
        StaticOrder t = b; t.c = b.c >> 1; if (!t.next(full, u)) return false;
        u.h = b.c & 1; return true;
    }
    __host__ __device__ int tail_busy() const {
        if (rem == 0) return 0;
        if (2 * rem > b.G) return rem;
        return 2 * rem;
    }
};

template <bool ROWPERM = false, bool HT = false, class Epi, class Sched>
__device__ __forceinline__ void gemm_phase(LAS unsigned char* lds, const Gemm g, const Sched& S, const Epi& E) {
    int tid_l = threadIdx.x; asm volatile("" : "+v"(tid_l));
    const int tid = tid_l, wid = __builtin_amdgcn_readfirstlane(tid >> 6), lane = tid & 63, wr = wid >> 2, wc = wid & 3, fr = lane & 15, fq = lane >> 4;
    const int K = g.K, nt = K / BK;
    unsigned voffA[2], voffB[2];
#pragma unroll
    for (int i = 0; i < 2; ++i) { int R, C; stage_rc(tid * 16 + i * 8192, R, C); const int Rb = (R & ~31) + perm32(R & 31);
        const int Ra = ROWPERM ? ((R & 64) | ((R & 15) << 2) | ((R >> 4) & 3)) : R;
        voffA[i] = (unsigned)(Ra * K + C) * 2u; voffB[i] = (unsigned)(Rb * K + C) * 2u; }
    const size_t kstep = (size_t)(BK * 2);
    const size_t hstep = (size_t)HALF * K * 2;
    const size_t tstep = 2 * hstep;
    const unsigned ldsw = (unsigned)wid * 1024u;
    const int aoff = lds_byte(wr * 64 + fr, fq * 8), boff = lds_byte(wc * 32 + fr, fq * 8);
#define PG8_SA(b, h) (((b) * 2 + (h)) * HTB)
#define PG8_SB(b, h) ((4 + (b) * 2 + (h)) * HTB)
#define PG8_STAGE(bufoff, gbase, voff) do { _Pragma("unroll") for (int _i = 0; _i < 2; ++_i) \
        __builtin_amdgcn_global_load_lds((const unsigned*)((const char*)(gbase) + (voff)[_i]), (LAS unsigned*)(lds + (bufoff) + ldsw + _i * 8192), 16, 0, 0); } while (0)
#define PG8_LDA(dst, b, h) do { _Pragma("unroll") for (int m = 0; m < 4; ++m) _Pragma("unroll") for (int k = 0; k < 2; ++k) dst[m][k] = *(const LAS bf16x8*)(lds + PG8_SA(b, h) + aoff + m * 2048 + k * 1024); } while (0)
#define PG8_LDB(dst, b, h) do { _Pragma("unroll") for (int n = 0; n < 2; ++n) _Pragma("unroll") for (int k = 0; k < 2; ++k) dst[n][k] = *(const LAS bf16x8*)(lds + PG8_SB(b, h) + boff + n * 2048 + k * 1024); } while (0)
#define PG8_MMA(ai, bj, At, Bt) do { __builtin_amdgcn_s_setprio(1); _Pragma("unroll") for (int m = 0; m < 4; ++m) _Pragma("unroll") for (int n = 0; n < 2; ++n) _Pragma("unroll") for (int k = 0; k < 2; ++k) \
        acc[ai][bj][m][n] = __builtin_amdgcn_mfma_f32_16x16x32_bf16(Bt[n][k], At[m][k], acc[ai][bj][m][n], 0, 0, 0); __builtin_amdgcn_s_setprio(0); } while (0)
#define PG8_WAIT_V(n) asm volatile("s_waitcnt vmcnt(" #n ")" ::: "memory")
#define PG8_WAIT_L(n) asm volatile("s_waitcnt lgkmcnt(" #n ")" ::: "memory")
#define PG8_BAR __builtin_amdgcn_s_barrier()
#define PG8_SCHED __builtin_amdgcn_sched_barrier(0)
    Unit cur, nxt; int ui = 0;
    if (!S.next(0, cur)) return;
    f32x4 acc[2][2][4][2];
#pragma unroll
    for (int a = 0; a < 2; ++a)
#pragma unroll
        for (int b = 0; b < 2; ++b)
#pragma unroll
            for (int m = 0; m < 4; ++m)
#pragma unroll
                for (int n = 0; n < 2; ++n) acc[a][b][m][n] = (f32x4){0.f, 0.f, 0.f, 0.f};
    bf16x8 At[4][2], B0[2][2], B1[2][2];
    const char* cA = (const char*)g.A + (size_t)cur.pm * tstep + ((HT && cur.h > 0) ? hstep : 0); const char* cB = (const char*)g.Bt + (size_t)cur.pn * tstep;
    size_t hsA = (HT && cur.h >= 0) ? 0 : hstep;
    PG8_STAGE(PG8_SB(0, 0), cB, voffB); PG8_STAGE(PG8_SB(0, 1), cB + hstep, voffB); PG8_STAGE(PG8_SA(0, 0), cA, voffA); PG8_STAGE(PG8_SA(0, 1), cA + hsA, voffA);
    if (wr == 1) PG8_BAR;
    PG8_WAIT_V(2); PG8_BAR;
    PG8_STAGE(PG8_SB(1, 0), cB + kstep, voffB); PG8_STAGE(PG8_SA(1, 0), cA + kstep, voffA); PG8_STAGE(PG8_SB(1, 1), cB + hstep + kstep, voffB);
    PG8_WAIT_V(6); PG8_BAR;
    for (;;) {
        const bool has_next = S.next(ui + 1, nxt);
        const char* nA = has_next ? (const char*)g.A + (size_t)nxt.pm * tstep + ((HT && nxt.h > 0) ? hstep : 0) : cA; const char* nB = has_next ? (const char*)g.Bt + (size_t)nxt.pn * tstep : cB;
        const size_t nhsA = has_next ? ((HT && nxt.h >= 0) ? (size_t)0 : hstep) : hsA;
        const bool full_u = !(HT && cur.h >= 0);
#define PG8_KLOOP(FULL) \
        for (int t = 0; t < nt; t += 2) { \
            const bool last = (t == nt - 2); \
            const char* a1 = cA + (size_t)(t + 1) * kstep; \
            const char* a2 = last ? nA : cA + (size_t)(t + 2) * kstep; const char* b2 = last ? nB : cB + (size_t)(t + 2) * kstep; \
            const char* a3 = a2 + kstep; const char* b3 = b2 + kstep; \
            const size_t hs2 = last ? nhsA : hsA; \
            PG8_LDB(B0, 0, 0); PG8_LDB(B1, 0, 1); PG8_SCHED; PG8_LDA(At, 0, 0); PG8_STAGE(PG8_SA(1, 1), a1 + hsA, voffA); \
            PG8_WAIT_V(8); PG8_WAIT_L(0); PG8_BAR; PG8_MMA(0, 0, At, B0); PG8_MMA(0, 1, At, B1); PG8_BAR; PG8_SCHED; \
            if (FULL) PG8_LDA(At, 0, 1); PG8_STAGE(PG8_SB(0, 0), b2, voffB); PG8_STAGE(PG8_SB(0, 1), b2 + hstep, voffB); PG8_STAGE(PG8_SA(0, 0), a2, voffA); \
            PG8_WAIT_V(8); PG8_WAIT_L(0); PG8_BAR; if (FULL) { PG8_MMA(1, 0, At, B0); PG8_MMA(1, 1, At, B1); } PG8_BAR; PG8_SCHED; \
            PG8_LDB(B0, 1, 0); PG8_LDB(B1, 1, 1); PG8_SCHED; PG8_LDA(At, 1, 0); PG8_STAGE(PG8_SA(0, 1), a2 + hs2, voffA); \
            PG8_WAIT_V(8); PG8_WAIT_L(0); PG8_BAR; PG8_MMA(0, 0, At, B0); PG8_MMA(0, 1, At, B1); PG8_BAR; PG8_SCHED; \
            if (FULL) PG8_LDA(At, 1, 1); PG8_STAGE(PG8_SB(1, 0), b3, voffB); PG8_STAGE(PG8_SB(1, 1), b3 + hstep, voffB); PG8_STAGE(PG8_SA(1, 0), a3, voffA); \
            PG8_WAIT_V(8); PG8_WAIT_L(0); PG8_BAR; if (FULL) { PG8_MMA(1, 0, At, B0); PG8_MMA(1, 1, At, B1); } PG8_BAR; PG8_SCHED; \
        }
        if (full_u) { PG8_KLOOP(true) } else { PG8_KLOOP(false) }
#undef PG8_KLOOP
        if (wr == 0) PG8_BAR;
        E(acc, cur, wr, wc, fr, fq, nxt, has_next, ui);
        if (!has_next) break;
#pragma unroll
        for (int a = 0; a < 2; ++a)
#pragma unroll
            for (int b = 0; b < 2; ++b)
#pragma unroll
                for (int m = 0; m < 4; ++m)
#pragma unroll
                    for (int n = 0; n < 2; ++n) acc[a][b][m][n] = (f32x4){0.f, 0.f, 0.f, 0.f};
        cur = nxt; cA = nA; cB = nB; hsA = nhsA; ++ui;
        if (wr == 1) PG8_BAR;
    }
    PG8_WAIT_V(0);
    PG8_BAR;
#undef PG8_SA
#undef PG8_SB
#undef PG8_STAGE
#undef PG8_LDA
#undef PG8_LDB
#undef PG8_MMA
#undef PG8_WAIT_V
#undef PG8_WAIT_L
#undef PG8_BAR
#undef PG8_SCHED
}
}

struct EpiInProj {
    bf16_t* P; const float* qw; const float* kw; float qscale;
    __device__ __forceinline__ void operator()(const f32x4 (&acc)[2][2][4][2], const pg8::Unit& u, int wr, int wc, int fr_in, int fq_in, const pg8::Unit&, bool, int) const {
        int fr = fr_in, fq = fq_in; asm volatile("" : "+v"(fr), "+v"(fq));
        const int nai = u.h < 0 ? 2 : 1, rowh = u.pm * 256 + (u.h > 0 ? 128 : 0);
        const int tile = u.pn;
        const bool isq = tile < 2, isk = (tile == 2) && (wc < 2);
        const bool nrm = isq || isk;
        f32x4 gw[2][2];
#pragma unroll
        for (int bj = 0; bj < 2; ++bj)
#pragma unroll
            for (int n = 0; n < 2; ++n) {
                const int d = 32 * bj + 8 * fq + 4 * n;
                f32x4 w = (f32x4){1.f, 1.f, 1.f, 1.f};
                if (isq) w = *(const f32x4*)(qw + d) * qscale; else if (isk) w = *(const f32x4*)(kw + d);
                gw[bj][n] = w;
            }
        if (tile >= 5) {
            const int colc = COL_CU + 128 * (tile - 5) + 32 * wc + 8 * fq;
#pragma unroll
            for (int ai = 0; ai < 2; ++ai)
#pragma unroll
                for (int m = 0; m < 4; ++m) {
                    if (ai >= nai) continue;
                    const int row = rowh + ai * 128 + wr * 64 + m * 16 + fr;
                    const f32x4 a = acc[ai][0][m][0] * acc[ai][1][m][0], b = acc[ai][0][m][1] * acc[ai][1][m][1];
                    u32x4 w; w.x = cvtpk(a[0], a[1]); w.y = cvtpk(a[2], a[3]); w.z = cvtpk(b[0], b[1]); w.w = cvtpk(b[2], b[3]);
                    *(u32x4*)(P + (size_t)row * PW + colc) = w;
                }
            return;
        }
        const int colb = 256 * tile + 64 * wc + 8 * fq;
#pragma unroll
        for (int ai = 0; ai < 2; ++ai)
#pragma unroll
            for (int m = 0; m < 4; ++m) {
                if (ai >= nai) continue;
                    const int row = rowh + ai * 128 + wr * 64 + m * 16 + fr;
                f32x4 v[2][2];
#pragma unroll
                for (int bj = 0; bj < 2; ++bj)
#pragma unroll
                    for (int n = 0; n < 2; ++n) v[bj][n] = acc[ai][bj][m][n];
                if (nrm) {
                    float ss = 0.f;
#pragma unroll
                    for (int bj = 0; bj < 2; ++bj)
#pragma unroll
                        for (int n = 0; n < 2; ++n) { const f32x4 x = v[bj][n]; ss += (x[0] * x[0] + x[1] * x[1]) + (x[2] * x[2] + x[3] * x[3]); }
                    ss += __shfl_xor(ss, 16); ss += __shfl_xor(ss, 32);
                    const float r = fast_rsqrt(ss * (1.0f / 64.0f) + EPS);
#pragma unroll
                    for (int bj = 0; bj < 2; ++bj)
#pragma unroll
                        for (int n = 0; n < 2; ++n) v[bj][n] = v[bj][n] * r * gw[bj][n];
                }
                bf16_t* rowp = P + (size_t)row * PW + colb;
#pragma unroll
                for (int bj = 0; bj < 2; ++bj) {
                    u32x4 w; w.x = cvtpk(v[bj][0][0], v[bj][0][1]); w.y = cvtpk(v[bj][0][2], v[bj][0][3]); w.z = cvtpk(v[bj][1][0], v[bj][1][1]); w.w = cvtpk(v[bj][1][2], v[bj][1][3]);
                    *(u32x4*)(rowp + 32 * bj) = w;
                }
            }
    }
};

struct EpiOutProj {
    const float* x; bf16_t* xn; float* part;
    __device__ __forceinline__ void operator()(const f32x4 (&acc)[2][2][4][2], const pg8::Unit& u, int wr, int wc, int fr_in, int fq_in, const pg8::Unit&, bool, int) const {
        int fr = fr_in, fq = fq_in; asm volatile("" : "+v"(fr), "+v"(fq));
        const int col0 = u.pn * 256 + wc * 32 + 8 * fq;
#pragma unroll
        for (int ai = 0; ai < 2; ++ai)
#pragma unroll
            for (int m = 0; m < 4; ++m) {
                const int row = u.pm * 256 + ai * 128 + wr * 64 + m * 16 + fr;
                const size_t off = (size_t)row * DM + col0;
                float ss = 0.f;
#pragma unroll
                for (int bj = 0; bj < 2; ++bj) {
                    const f32x4 x0 = __builtin_nontemporal_load((const f32x4*)(x + off + bj * 128)), x1 = __builtin_nontemporal_load((const f32x4*)(x + off + bj * 128 + 4));
                    const f32x4 a = x0 + acc[ai][bj][m][0], b = x1 + acc[ai][bj][m][1];
                    ss += (a[0] * a[0] + a[1] * a[1]) + (a[2] * a[2] + a[3] * a[3]) + (b[0] * b[0] + b[1] * b[1]) + (b[2] * b[2] + b[3] * b[3]);
                    u32x4 w; w.x = cvtpk(a[0], a[1]); w.y = cvtpk(a[2], a[3]); w.z = cvtpk(b[0], b[1]); w.w = cvtpk(b[2], b[3]);
                    *(u32x4*)(xn + off + bj * 128) = w;
                }
                ss += __shfl_xor(ss, 16); ss += __shfl_xor(ss, 32);
                if (fq == 0) part[(size_t)row * 16 + u.pn * 4 + wc] = ss;
            }
    }
};

struct EpiDown {
    const bf16_t* xn; float* out;
    __device__ __forceinline__ void operator()(const f32x4 (&acc)[2][2][4][2], const pg8::Unit& u, int wr, int wc, int fr_in, int fq_in, const pg8::Unit&, bool, int) const {
        int fr = fr_in, fq = fq_in; asm volatile("" : "+v"(fr), "+v"(fq));
        const int col0 = u.pn * 256 + wc * 32 + 8 * fq;
#pragma unroll
        for (int ai = 0; ai < 2; ++ai)
#pragma unroll
            for (int m = 0; m < 4; ++m) {
                const int row = u.pm * 256 + ai * 128 + wr * 64 + m * 16 + fr;
                const size_t off = (size_t)row * DM + col0;
#pragma unroll
                for (int bj = 0; bj < 2; ++bj) {
                    const u32x4 r = __builtin_nontemporal_load((const u32x4*)(xn + off + bj * 128));
                    const f32x4 x0 = (f32x4){bflo(r.x), bfhi(r.x), bflo(r.y), bfhi(r.y)}, x1 = (f32x4){bflo(r.z), bfhi(r.z), bflo(r.w), bfhi(r.w)};
                    __builtin_nontemporal_store(x0 + acc[ai][bj][m][0], (f32x4*)(out + off + bj * 128)); __builtin_nontemporal_store(x1 + acc[ai][bj][m][1], (f32x4*)(out + off + bj * 128 + 4));
                }
            }
    }
};

__device__ __forceinline__ float dpp_shr1(float old, float src) { return __builtin_bit_cast(float, __builtin_amdgcn_update_dpp(__builtin_bit_cast(int, old), __builtin_bit_cast(int, src), 0x111, 0xf, 0xf, false)); }

struct EpiUpConv {
    bf16_t* act; const float* part; const float* cw; float* edge; LAS unsigned char* xch; mutable int rs_pm;
    __device__ __forceinline__ void operator()(f32x4 (&acc)[2][2][4][2], const pg8::Unit& u, int wr, int wc, int fr_in, int fq_in, const pg8::Unit& nxt, bool has_next, int ui) const {
        int fr = fr_in, fq = fq_in, tid = threadIdx.x;
        asm volatile("" : "+v"(fr), "+v"(fq), "+v"(tid));
        LAS f32x4* H = (LAS f32x4*)xch;
        LAS f32x4* CW = (LAS f32x4*)(xch + CWS_OFF) + (ui & 1) * 192;
        LAS f32x4* CWN = (LAS f32x4*)(xch + CWS_OFF) + ((ui + 1) & 1) * 192;
        LAS float* RS = (LAS float*)(xch + RS_OFF);
        const int nai = u.h < 0 ? 2 : 1, rbase = u.h > 0 ? 128 : 0;
        const int ctap = tid >> 6, cr = tid & 63;
        f32x4 cwv = (f32x4){0.f, 0.f, 0.f, 0.f}, cwn = (f32x4){0.f, 0.f, 0.f, 0.f};
        if (ui == 0 && tid < 192) cwv = *(const f32x4*)(cw + (size_t)ctap * NUP + (cr >> 5) * DFF + 128 * u.pn + 4 * (cr & 31));
        if (has_next && tid < 192) cwn = *(const f32x4*)(cw + (size_t)ctap * NUP + (cr >> 5) * DFF + 128 * nxt.pn + 4 * (cr & 31));
        if (u.pm != rs_pm) {
            if (tid < 256) {
                const float* pp = part + (size_t)(u.pm * 256 + tid) * 16;
                const f32x4 p0 = *(const f32x4*)pp, p1 = *(const f32x4*)(pp + 4), p2 = *(const f32x4*)(pp + 8), p3 = *(const f32x4*)(pp + 12);
                const float s = ((p0[0] + p0[1]) + (p0[2] + p0[3])) + ((p1[0] + p1[1]) + (p1[2] + p1[3])) + ((p2[0] + p2[1]) + (p2[2] + p2[3])) + ((p3[0] + p3[1]) + (p3[2] + p3[3]));
                RS[tid] = fast_rsqrt(s * (1.0f / (float)DM) + EPS);
            }
            asm volatile("s_waitcnt lgkmcnt(0)" ::: "memory"); __builtin_amdgcn_s_barrier(); asm volatile("" ::: "memory");
            rs_pm = u.pm;
        }
#pragma unroll
        for (int ai = 0; ai < 2; ++ai)
#pragma unroll
            for (int m = 0; m < 4; ++m) {
                if (ai >= nai) continue;
                const float rs = RS[rbase + ai * 128 + wr * 64 + 4 * fr + m];
#pragma unroll
                for (int bj = 0; bj < 2; ++bj)
#pragma unroll
                    for (int n = 0; n < 2; ++n) acc[ai][bj][m][n] = acc[ai][bj][m][n] * rs;
            }
        if (ui == 0 && tid < 192) CW[tid] = cwv;
        if (fr == 15) {
#pragma unroll
            for (int ai = 0; ai < 2; ++ai)
#pragma unroll
                for (int bj = 0; bj < 2; ++bj)
#pragma unroll
                    for (int n = 0; n < 2; ++n) {
                        H[((((ai * 2 + wr) * 4 + wc) * 2 + 0) * 4 + (bj * 2 + n)) * 4 + fq] = acc[ai][bj][2][n];
                        H[((((ai * 2 + wr) * 4 + wc) * 2 + 1) * 4 + (bj * 2 + n)) * 4 + fq] = acc[ai][bj][3][n];
                    }
        }
        const int colg = 128 * u.pn + 32 * wc + 8 * fq;
        if (wr == 0 && fr == 0) {
#pragma unroll
            for (int rsel = 0; rsel < 2; ++rsel) {
                float* e = edge + ((size_t)(u.pm * 8 + (u.h > 0 ? 6 : 0) + rsel)) * NUP + colg;
#pragma unroll
                for (int bj = 0; bj < 2; ++bj)
#pragma unroll
                    for (int n = 0; n < 2; ++n) *(f32x4*)(e + bj * DFF + 4 * n) = acc[0][bj][rsel][n];
            }
        }
        if (wr == 1 && fr == 15) {
#pragma unroll
            for (int rsel = 0; rsel < 2; ++rsel) {
                float* e = edge + ((size_t)(u.pm * 8 + (u.h == 0 ? 4 : 2) + rsel)) * NUP + colg;
#pragma unroll
                for (int bj = 0; bj < 2; ++bj)
#pragma unroll
                    for (int n = 0; n < 2; ++n) *(f32x4*)(e + bj * DFF + 4 * n) = (nai == 2) ? acc[1][bj][2 + rsel][n] : acc[0][bj][2 + rsel][n];
            }
        }
        asm volatile("s_waitcnt lgkmcnt(0)" ::: "memory"); __builtin_amdgcn_s_barrier(); asm volatile("" ::: "memory");
        const int cwi = 8 * wc + 2 * fq;
#pragma unroll
        for (int ai = 0; ai < 2; ++ai) {
            if (ai >= nai) continue;
            const int chunk = ai * 2 + wr;
            const int pch = chunk > 0 ? chunk - 1 : 0;
            u32x2 res[4][2];
#pragma unroll
            for (int n = 0; n < 2; ++n) {
                f32x4 y[2][4];
#pragma unroll
                for (int bj = 0; bj < 2; ++bj) {
                    const f32x4 w0 = CW[cwi + 32 * bj + n], w1 = CW[64 + cwi + 32 * bj + n], w2 = CW[128 + cwi + 32 * bj + n];
                    const f32x4 h62 = H[(((pch * 4 + wc) * 2 + 0) * 4 + (bj * 2 + n)) * 4 + fq], h63 = H[(((pch * 4 + wc) * 2 + 1) * 4 + (bj * 2 + n)) * 4 + fq];
                    const f32x4 x0 = acc[ai][bj][0][n], x1 = acc[ai][bj][1][n], x2 = acc[ai][bj][2][n], x3 = acc[ai][bj][3][n];
                    f32x4 p2, p3;
#pragma unroll
                    for (int j = 0; j < 4; ++j) { p2[j] = dpp_shr1(h62[j], x2[j]); p3[j] = dpp_shr1(h63[j], x3[j]); }
                    y[bj][0] = w2 * x0 + w1 * p3 + w0 * p2;
                    y[bj][1] = w2 * x1 + w1 * x0 + w0 * p3;
                    y[bj][2] = w2 * x2 + w1 * x1 + w0 * x0;
                    y[bj][3] = w2 * x3 + w1 * x2 + w0 * x1;
                }
#pragma unroll
                for (int m = 0; m < 4; ++m) {
                    const f32x4 g = y[0][m], v = y[1][m];
                    res[m][n].x = cvtpk(siluf(g[0]) * v[0], siluf(g[1]) * v[1]); res[m][n].y = cvtpk(siluf(g[2]) * v[2], siluf(g[3]) * v[3]);
                }
            }
#pragma unroll
            for (int m = 0; m < 4; ++m) {
                const int rt = ai * 128 + wr * 64 + 4 * fr + m;
                if (rt >= 2) { u32x4 w; w.x = res[m][0].x; w.y = res[m][0].y; w.z = res[m][1].x; w.w = res[m][1].y;
                    *(u32x4*)(act + (size_t)(u.pm * 256 + rbase + rt) * DFF + colg) = w; }
            }
        }
        if (has_next && tid < 192) CWN[tid] = cwn;
    }
};

__device__ __forceinline__ float wave_sum(float v) {
#pragma unroll
    for (int o = 1; o < 64; o <<= 1) v += __shfl_xor(v, o);
    return v;
}
template <int MODE>
__device__ __forceinline__ void p0_transpose_item(const float* W, int K, int N, bf16_t* WT, const float* gain, LAS float* scr, int item, int lane) {
    const int nblk = N / 32, kb = item / nblk, nb = item % nblk, k0 = 64 * kb, n0 = 32 * nb;
    int p0;
    if (MODE == 0) p0 = n0;
    else if (MODE == 1) {
        if (n0 < COL_C) { const int tile = n0 >> 8, c = n0 & 255, wc = c >> 6, bj = (c >> 5) & 1; p0 = tile * 256 + 128 * bj + 32 * wc; }
        else if (n0 < COL_U) { const int cc = n0 - COL_C; p0 = (5 + (cc >> 7)) * 256 + (cc & 127); }
        else { const int uc = n0 - COL_U; p0 = (5 + (uc >> 7)) * 256 + 128 + (uc & 127); }
    }
    else { if (n0 < DFF) p0 = 256 * (n0 >> 7) + (n0 & 127); else { const int n1 = n0 - DFF; p0 = 256 * (n1 >> 7) + 128 + (n1 & 127); } }
#pragma unroll 8
    for (int i = 0; i < 32; ++i) { const int kk = 2 * i + (lane >> 5); float v = __builtin_nontemporal_load(W + (size_t)(k0 + kk) * N + n0 + (lane & 31)); if (MODE == 2) v *= gain[k0 + kk]; scr[kk * 33 + (lane & 31)] = v; }
    asm volatile("s_waitcnt lgkmcnt(0)" ::: "memory");
    const int c = lane & 7;
#pragma unroll
    for (int j = 0; j < 4; ++j) { const int n = (lane >> 3) + 8 * j; const LAS float* s = scr + (8 * c) * 33 + n;
        u32x4 o; o.x = cvtpk(s[0 * 33], s[1 * 33]); o.y = cvtpk(s[2 * 33], s[3 * 33]); o.z = cvtpk(s[4 * 33], s[5 * 33]); o.w = cvtpk(s[6 * 33], s[7 * 33]);
        *(u32x4*)(WT + (size_t)(p0 + n) * K + k0 + 8 * c) = o; }
    asm volatile("s_waitcnt lgkmcnt(0)" ::: "memory");
}

namespace p2 {
constexpr int KPITCH = 72;
constexpr int KS_BYTES = 2 * 192 * KPITCH * 2;
constexpr int VT_OFF = KS_BYTES, VT_BYTES = 2 * 208 * KPITCH * 2;
constexpr int SS_OFF = VT_OFF + VT_BYTES;
static_assert(SS_OFF + 2048 <= RING_BYTES, "P2 LDS");
static_assert(XCH_OFF + RS_OFF + 1024 <= LDS_BYTES && MISC_OFF + 128 <= XCH_OFF + CWS_OFF, "exchange LDS map");
}

struct Args { const float* in[14]; float* out; unsigned char* ws; int cg_flag; int pad; };

__device__ __forceinline__ void p2_unit(LAS unsigned char* lds, const bf16_t* __restrict__ proj, bf16_t* __restrict__ mix, const float* __restrict__ sinks, const float* __restrict__ aw,
                                        const float* __restrict__ cmw, const float* __restrict__ cow, int unit, int tid, int lane, int wave) {
    using namespace p2;
    asm volatile("" : "+v"(tid), "+v"(lane));
    const int q0 = unit * 64;
    u32x4 kreg[6], vreg[6];
#pragma unroll
    for (int i = 0; i < 6; ++i) {
        const int id = i * 512 + tid, c = id & 7, rest = id >> 3, kv = rest / 192, kidx = rest - kv * 192, tok = q0 - 128 + kidx;
        kreg[i] = (u32x4){0u, 0u, 0u, 0u}; vreg[i] = (u32x4){0u, 0u, 0u, 0u};
        if (tok >= 0) { const bf16_t* src = proj + (size_t)tok * PW; kreg[i] = *(const u32x4*)(src + COL_K + 64 * kv + 8 * c); vreg[i] = *(const u32x4*)(src + COL_V + 64 * kv + 8 * c); }
    }
    __builtin_amdgcn_sched_barrier(0);
    const int c0 = 8 * lane, t0 = q0 + 8 * wave;
    u32x4 Cv[10], Bv[8];
#define P2_LOAD_CU(i) do { const int t_ = t0 - 2 + (i); Cv[i] = (u32x4){0u, 0u, 0u, 0u}; \
        if (t_ >= 0) Cv[i] = __builtin_nontemporal_load((const u32x4*)(proj + (size_t)t_ * PW + c0 + COL_CU)); } while (0)
#define P2_LOAD_B(i) do { Bv[i] = __builtin_nontemporal_load((const u32x4*)(proj + (size_t)(t0 + (i)) * PW + c0 + COL_B)); } while (0)
    P2_LOAD_CU(0); P2_LOAD_CU(1); P2_LOAD_CU(2); P2_LOAD_CU(3); P2_LOAD_CU(4); P2_LOAD_CU(5);
    P2_LOAD_B(0); P2_LOAD_B(1); P2_LOAD_B(2); P2_LOAD_B(3);
    float w0[8], w1[8], w2[8], gn[8];
#pragma unroll
    for (int hf = 0; hf < 2; ++hf) {
        const f32x4 a = *(const f32x4*)(cmw + c0 + 4 * hf), b = *(const f32x4*)(cmw + 512 + c0 + 4 * hf), c = *(const f32x4*)(cmw + 1024 + c0 + 4 * hf), d = *(const f32x4*)(cow + c0 + 4 * hf);
#pragma unroll
        for (int e = 0; e < 4; ++e) { w0[4 * hf + e] = a[e]; w1[4 * hf + e] = b[e]; w2[4 * hf + e] = c[e]; gn[4 * hf + e] = d[e]; }
    }
    __builtin_amdgcn_sched_barrier(0);
#pragma unroll
    for (int i = 0; i < 6; ++i) {
        const int id = i * 512 + tid, c = id & 7, rest = id >> 3, kv = rest / 192, kidx = rest - kv * 192;
        *(LAS u32x4*)(lds + ((kv * 192 + kidx) * KPITCH + 8 * c) * 2) = kreg[i];
        *(LAS u32x4*)(lds + VT_OFF + ((kv * 208 + kidx) * KPITCH + 8 * c) * 2) = vreg[i];
    }
    if (tid < 256) { const int kv = tid >> 7, r = (tid >> 3) & 15, c = tid & 7; *(LAS u32x4*)(lds + VT_OFF + ((kv * 208 + 192 + r) * KPITCH + 8 * c) * 2) = (u32x4){0u, 0u, 0u, 0u}; }
    __builtin_amdgcn_sched_barrier(0);
    P2_LOAD_CU(6); P2_LOAD_CU(7); P2_LOAD_CU(8); P2_LOAD_CU(9);
    P2_LOAD_B(4); P2_LOAD_B(5); P2_LOAD_B(6); P2_LOAD_B(7);
    __builtin_amdgcn_sched_barrier(0);
    float cm2[8], cm1[8];
#define P2_CONV_STEP(i) do { const u32x4 C = Cv[i]; float cu[8]; \
        cu[0] = bflo(C.x); cu[1] = bfhi(C.x); cu[2] = bflo(C.y); cu[3] = bfhi(C.y); cu[4] = bflo(C.z); cu[5] = bfhi(C.z); cu[6] = bflo(C.w); cu[7] = bfhi(C.w); \
        if ((i) >= 2) { const u32x4 B = Bv[(i) >= 2 ? (i) - 2 : 0]; \
            const float bb[8] = {bflo(B.x), bfhi(B.x), bflo(B.y), bfhi(B.y), bflo(B.z), bfhi(B.z), bflo(B.w), bfhi(B.w)}; \
            float cv[8]; float ss = 0.f; \
            _Pragma("unroll") for (int e = 0; e < 8; ++e) { const float y = w0[e] * cm2[e] + w1[e] * cm1[e] + w2[e] * cu[e]; cv[e] = bb[e] * y; ss += cv[e] * cv[e]; } \
            ss = wave_sum(ss); \
            const float r = fast_rsqrt(ss * (1.0f / 512.0f) + EPS); \
            u32x4 w; w.x = cvtpk(cv[0] * r * gn[0], cv[1] * r * gn[1]); w.y = cvtpk(cv[2] * r * gn[2], cv[3] * r * gn[3]); \
            w.z = cvtpk(cv[4] * r * gn[4], cv[5] * r * gn[5]); w.w = cvtpk(cv[6] * r * gn[6], cv[7] * r * gn[7]); \
            *(u32x4*)(mix + (size_t)(t0 + (i) - 2) * DM + 512 + c0) = w; } \
        _Pragma("unroll") for (int e = 0; e < 8; ++e) { cm2[e] = ((i) == 0) ? 0.f : cm1[e]; cm1[e] = cu[e]; } } while (0)
    P2_CONV_STEP(0); P2_CONV_STEP(1); P2_CONV_STEP(2); P2_CONV_STEP(3); P2_CONV_STEP(4); P2_CONV_STEP(5);
    __builtin_amdgcn_sched_barrier(0);
    const int h = wave, kvh = h >> 2, fr = lane & 15, fq = lane >> 4;
    bf16x8 Qf[4][2];
#pragma unroll
    for (int qt = 0; qt < 4; ++qt) {
        const bf16_t* qp = proj + (size_t)(q0 + 16 * qt + fr) * PW + 64 * h + 8 * fq;
        Qf[qt][0] = __builtin_nontemporal_load((const bf16x8*)qp); Qf[qt][1] = __builtin_nontemporal_load((const bf16x8*)(qp + 32));
    }
    const float sink2 = sinks[h] * LOG2E;
    __builtin_amdgcn_sched_barrier(0);
    P2_CONV_STEP(6); P2_CONV_STEP(7); P2_CONV_STEP(8); P2_CONV_STEP(9);
#undef P2_LOAD_CU
#undef P2_LOAD_B
#undef P2_CONV_STEP
    __syncthreads();
    LAS float* SSf = (LAS float*)(lds + SS_OFF);
    const bool early = q0 < 128;
    f32x4 O[4][4];
#pragma unroll
    for (int qt = 0; qt < 4; ++qt) {
        const bf16x8 Q0 = Qf[qt][0], Q1 = Qf[qt][1];
        f32x4 S[9];
#pragma unroll
        for (int kt = 0; kt < 9; ++kt) {
            const LAS unsigned char* kp = lds + ((kvh * 192 + 16 * (qt + kt) + fr) * KPITCH + 8 * fq) * 2;
            const bf16x8 K0 = *(const LAS bf16x8*)kp, K1 = *(const LAS bf16x8*)(kp + 64);
            f32x4 a = (f32x4){0.f, 0.f, 0.f, 0.f};
            a = __builtin_amdgcn_mfma_f32_16x16x32_bf16(K0, Q0, a, 0, 0, 0);
            a = __builtin_amdgcn_mfma_f32_16x16x32_bf16(K1, Q1, a, 0, 0, 0);
            S[kt] = a;
        }
        float mx = sink2;
#pragma unroll
        for (int kt = 0; kt < 9; ++kt)
#pragma unroll
            for (int j = 0; j < 4; ++j) {
                const int jt = q0 - 128 + 16 * (qt + kt) + 4 * fq + j;
                bool valid = early ? (jt >= 0) : true;
                if (kt == 0) valid = valid && (fr < 4 * fq + j);
                if (kt == 8) valid = valid && (fr >= 4 * fq + j);
                const float sv = valid ? S[kt][j] : -1e30f;
                S[kt][j] = sv; mx = fmaxf(mx, sv);
            }
        mx = fmaxf(mx, __shfl_xor(mx, 16)); mx = fmaxf(mx, __shfl_xor(mx, 32));
        float l = 0.f;
#pragma unroll
        for (int kt = 0; kt < 9; ++kt)
#pragma unroll
            for (int j = 0; j < 4; ++j) { const float p = __builtin_amdgcn_exp2f(S[kt][j] - mx); S[kt][j] = p; l += p; }
        l += __shfl_xor(l, 16); l += __shfl_xor(l, 32);
        l += __builtin_amdgcn_exp2f(sink2 - mx);
        const float inv = __builtin_amdgcn_rcpf(l);
        bf16x8 pb[5];
#pragma unroll
        for (int s2 = 0; s2 < 5; ++s2) {
            u32x4 w; w.x = cvtpk(S[2 * s2][0], S[2 * s2][1]); w.y = cvtpk(S[2 * s2][2], S[2 * s2][3]);
            if (2 * s2 + 1 < 9) { w.z = cvtpk(S[2 * s2 + 1 < 9 ? 2 * s2 + 1 : 0][0], S[2 * s2 + 1 < 9 ? 2 * s2 + 1 : 0][1]); w.w = cvtpk(S[2 * s2 + 1 < 9 ? 2 * s2 + 1 : 0][2], S[2 * s2 + 1 < 9 ? 2 * s2 + 1 : 0][3]); }
            else { w.z = 0u; w.w = 0u; }
            pb[s2] = __builtin_bit_cast(bf16x8, w);
        }
#pragma unroll
        for (int dt = 0; dt < 4; ++dt) {
            f32x4 o = (f32x4){0.f, 0.f, 0.f, 0.f};
#pragma unroll
            for (int s2 = 0; s2 < 5; ++s2) {
                const LAS unsigned char* vp = lds + VT_OFF + ((kvh * 208 + 16 * (qt + 2 * s2) + 4 * fq + (fr >> 2)) * KPITCH + 16 * dt + 4 * (fr & 3)) * 2;
                const s16x4 lo = __builtin_amdgcn_ds_read_tr16_b64_v4i16((LAS s16x4*)vp), hi = __builtin_amdgcn_ds_read_tr16_b64_v4i16((LAS s16x4*)(vp + 16 * KPITCH * 2));
                const bf16x8 vfb = (bf16x8){lo[0], lo[1], lo[2], lo[3], hi[0], hi[1], hi[2], hi[3]};
                o = __builtin_amdgcn_mfma_f32_16x16x32_bf16(vfb, pb[s2], o, 0, 0, 0);
            }
            O[qt][dt] = o * inv;
        }
        float ss = 0.f;
#pragma unroll
        for (int dt = 0; dt < 4; ++dt) { const f32x4 o = O[qt][dt]; ss += (o[0] * o[0] + o[1] * o[1]) + (o[2] * o[2] + o[3] * o[3]); }
        ss += __shfl_xor(ss, 16); ss += __shfl_xor(ss, 32);
        if (fq == 0) SSf[h * 64 + 16 * qt + fr] = ss;
    }
    __syncthreads();
#pragma unroll
    for (int qt = 0; qt < 4; ++qt) {
        float tot = 0.f;
#pragma unroll
        for (int hh = 0; hh < 8; ++hh) tot += SSf[hh * 64 + 16 * qt + fr];
        const float r = fast_rsqrt(tot * (1.0f / 512.0f) + EPS);
        bf16_t* mp = mix + (size_t)(q0 + 16 * qt + fr) * DM + 64 * h + 4 * fq;
#pragma unroll
        for (int dt = 0; dt < 4; ++dt) {
            const f32x4 g = *(const f32x4*)(aw + 64 * h + 16 * dt + 4 * fq);
            const f32x4 v = O[qt][dt] * r * g;
            u32x2 w; w.x = cvtpk(v[0], v[1]); w.y = cvtpk(v[2], v[3]);
            *(u32x2*)(mp + 16 * dt) = w;
        }
    }
    __syncthreads();
}

#define XB_TMO      128
#define XB_XCNT(j)  (256  + 64 * (j))
#define XB_XSUB(j)  (1280 + 64 * (j))
#define XB_XGEN(j)  (2304 + 64 * (j))
#define XB_TOP      3328
#define XB_TOPGEN   3392
#define XCD_BAR_WORDS 3456
#define XB_SPIN_CAP (1u << 18)
__device__ __forceinline__ unsigned xb_ld(unsigned* p)              { return __hip_atomic_load(p, __ATOMIC_RELAXED, __HIP_MEMORY_SCOPE_AGENT); }
__device__ __forceinline__ unsigned xb_add(unsigned* p, unsigned v) { return __hip_atomic_fetch_add(p, v, __ATOMIC_RELAXED, __HIP_MEMORY_SCOPE_AGENT); }
__device__ __forceinline__ unsigned xb_xcc_id() { return (unsigned)__builtin_amdgcn_s_getreg((3 << 11) | 20) & 0xFu; }
#define XB_SPIN(cond, bar) do { unsigned _sp = 0; while (cond) { __builtin_amdgcn_s_sleep(1); \
    if ((++_sp & 255u) == 0u) { if (xb_ld(&(bar)[XB_TMO])) break; if (_sp > XB_SPIN_CAP) { atomicAdd(&(bar)[XB_TMO], 1u); break; } } } } while (0)
struct XcdBarrier { unsigned* bar; unsigned x; volatile LAS unsigned* st; };
__device__ __forceinline__ XcdBarrier xcd_barrier_post(unsigned* bar, volatile LAS unsigned* st) {
    XcdBarrier b; b.bar = bar; b.x = xb_xcc_id(); b.st = st;
    if (threadIdx.x == 0) (void)xb_add(&bar[XB_XCNT(b.x)], 1u);
    return b;
}
__device__ __forceinline__ void xcd_barrier_complete(unsigned* bar, unsigned x, unsigned& nloc, unsigned& nx) {
    const unsigned G = gridDim.x * gridDim.y * gridDim.z;
    unsigned sum, cnt, mine, sp = 0u;
    for (;;) {
        sum = 0u; cnt = 0u; mine = 0u;
#pragma unroll
        for (unsigned j = 0; j < 16; ++j) { const unsigned c = xb_ld(&bar[XB_XCNT(j)]); sum += c; cnt += (c > 0u) ? 1u : 0u; mine = (j == x) ? c : mine; }
        if (sum == G) break;
        __builtin_amdgcn_s_sleep(1);
        if ((++sp & 255u) == 0u) { if (xb_ld(&bar[XB_TMO])) break; if (sp > XB_SPIN_CAP) { atomicAdd(&bar[XB_TMO], 1u); break; } }
    }
    nloc = mine > 0u ? mine : 1u; nx = cnt > 0u ? cnt : 1u;
}
__device__ __forceinline__ void xcd_barrier(const XcdBarrier& b) {
    asm volatile("s_waitcnt vmcnt(0)" ::: "memory");
    __syncthreads();
    if (threadIdx.x == 0) {
        unsigned* bar = b.bar;
        __builtin_amdgcn_s_waitcnt(0);
        unsigned nloc = b.st[0], nx = b.st[1];
        if (nloc == 0u) { xcd_barrier_complete(bar, b.x, nloc, nx); b.st[0] = nloc; b.st[1] = nx; }
        const unsigned old = xb_add(&bar[XB_XSUB(b.x)], 1u);
        const unsigned gen = old / nloc;
        if (old + 1u == (gen + 1u) * nloc) {
            __builtin_amdgcn_fence(__ATOMIC_RELEASE, "agent");
            asm volatile("s_waitcnt vmcnt(0)" ::: "memory");
            const unsigned og = xb_add(&bar[XB_TOP], 1u);
            const unsigned tg = og / nx;
            if (og + 1u == (tg + 1u) * nx) xb_add(&bar[XB_TOPGEN], 1u);
            else XB_SPIN(xb_ld(&bar[XB_TOPGEN]) == tg, bar);
            __builtin_amdgcn_fence(__ATOMIC_ACQUIRE, "agent");
            xb_add(&bar[XB_XGEN(b.x)], 1u);
            asm volatile("s_waitcnt vmcnt(0)" ::: "memory");
        } else {
            XB_SPIN(xb_ld(&bar[XB_XGEN(b.x)]) == gen, bar);
            __builtin_amdgcn_fence(__ATOMIC_ACQUIRE, "agent");
            asm volatile("s_waitcnt vmcnt(0)" ::: "memory");
        }
    }
    __syncthreads();
}

__device__ __forceinline__ void fix_rows(bf16_t* dst, const float* cw, const float* et, const float* e1, const float* e2, int f0) {
    float yv[2][8];
#pragma unroll
    for (int bj = 0; bj < 2; ++bj)
#pragma unroll
        for (int hf = 0; hf < 2; ++hf) {
            const int col = bj * DFF + f0 + 4 * hf;
            const f32x4 w0 = *(const f32x4*)(cw + col), w1 = *(const f32x4*)(cw + NUP + col), w2 = *(const f32x4*)(cw + 2 * NUP + col);
            const f32x4 z = (f32x4){0.f, 0.f, 0.f, 0.f};
            const f32x4 xt = *(const f32x4*)(et + col), x1 = e1 ? *(const f32x4*)(e1 + col) : z, x2 = e2 ? *(const f32x4*)(e2 + col) : z;
            const f32x4 y = w0 * x2 + w1 * x1 + w2 * xt;
#pragma unroll
            for (int e = 0; e < 4; ++e) yv[bj][4 * hf + e] = y[e];
        }
    u32x4 w; w.x = cvtpk(siluf(yv[0][0]) * yv[1][0], siluf(yv[0][1]) * yv[1][1]); w.y = cvtpk(siluf(yv[0][2]) * yv[1][2], siluf(yv[0][3]) * yv[1][3]);
    w.z = cvtpk(siluf(yv[0][4]) * yv[1][4], siluf(yv[0][5]) * yv[1][5]); w.w = cvtpk(siluf(yv[0][6]) * yv[1][6], siluf(yv[0][7]) * yv[1][7]);
    *(u32x4*)dst = w;
}

__device__ __forceinline__ void convert_w_in(const Args& a, bf16_t* Win_t, LAS float* scr, int gw, int NGW, int lane) {
    constexpr int I_IN = (DM / 64) * (NIN / 32);
    for (int it = gw; it < I_IN; it += NGW) p0_transpose_item<1>(a.in[2], DM, NIN, Win_t, nullptr, scr, it, lane);
}
__device__ __forceinline__ void convert_w_out_up(const Args& a, bf16_t* Wout_t, bf16_t* Wup_t, LAS float* scr, int gw, int NGW, int lane) {
    constexpr int I_OUT = (DM / 64) * (DM / 32), I_UP = (DM / 64) * (NUP / 32);
    for (int it = gw; it < I_OUT + I_UP; it += NGW) {
        if (it < I_OUT) p0_transpose_item<0>(a.in[9], DM, DM, Wout_t, nullptr, scr, it, lane);
        else p0_transpose_item<2>(a.in[11], DM, NUP, Wup_t, a.in[10], scr, it - I_OUT, lane);
    }
}
__device__ __forceinline__ void convert_w_down(const Args& a, bf16_t* Wdn_t, LAS float* scr, int gw, int NGW, int lane) {
    constexpr int I_DN = (DFF / 64) * (DM / 32);
    for (int it = gw; it < I_DN; it += NGW) p0_transpose_item<0>(a.in[13], DFF, DM, Wdn_t, nullptr, scr, it, lane);
}

__global__ void __launch_bounds__(512, 2) fwd_megakernel(Args a) {
    extern __shared__ __attribute__((aligned(16))) unsigned char lds_raw[];
    LAS unsigned char* lds = (LAS unsigned char*)lds_raw;
    cg::grid_group grid = cg::this_grid();
    const int tid = threadIdx.x, lane = tid & 63, wave = __builtin_amdgcn_readfirstlane(tid >> 6);
    const int G = gridDim.x, bx = blockIdx.x;
    unsigned char* ws = a.ws;
    volatile LAS unsigned* MISC = (volatile LAS unsigned*)(lds + MISC_OFF);
    if (tid < 32) MISC[tid] = 0u;
    __syncthreads();
    const XcdBarrier bar = xcd_barrier_post((unsigned*)(ws + WS_CTL), MISC + 8);
    if (a.cg_flag) grid.sync();
#define GRID_BAR() xcd_barrier(bar)
    const float* x = a.in[0]; float* out = a.out;
    bf16_t* Win_t = (bf16_t*)(ws + WS_WIN); bf16_t* Wout_t = (bf16_t*)(ws + WS_WOUT); bf16_t* Wup_t = (bf16_t*)(ws + WS_WUP); bf16_t* Wdn_t = (bf16_t*)(ws + WS_WDN);
    float* part = (float*)(ws + WS_PART); float* edge = (float*)(ws + WS_EDGE);
    bf16_t* XN = (bf16_t*)(ws + WS_XN); bf16_t* proj = (bf16_t*)(ws + WS_PROJ); bf16_t* mix = (bf16_t*)(ws + WS_MIX); bf16_t* act = (bf16_t*)(ws + WS_ACT);
    LAS float* scr = (LAS float*)(lds + wave * 16384);

    {
        const int gw = bx * 8 + wave, NGW = G * 8;
        convert_w_in(a, Win_t, scr, gw, NGW, lane);
        const float* gw1 = a.in[1];
        f32x4 gv[4];
#pragma unroll
        for (int j = 0; j < 4; ++j) gv[j] = *(const f32x4*)(gw1 + 4 * lane + 256 * j);
        for (int m = gw; m < SEQ; m += 4 * NGW) {
            f32x4 v[4][4];
#pragma unroll
            for (int rr = 0; rr < 4; ++rr) {
                const int mr = m + rr * NGW;
                const f32x4* xr = (const f32x4*)(x + (size_t)(mr < SEQ ? mr : m) * DM) + lane;
#pragma unroll
                for (int j = 0; j < 4; ++j) v[rr][j] = __builtin_nontemporal_load(xr + 64 * j);
            }
#pragma unroll
            for (int rr = 0; rr < 4; ++rr) {
                const int mr = m + rr * NGW;
                float s = 0.f;
#pragma unroll
                for (int j = 0; j < 4; ++j) s += (v[rr][j][0] * v[rr][j][0] + v[rr][j][1] * v[rr][j][1]) + (v[rr][j][2] * v[rr][j][2] + v[rr][j][3] * v[rr][j][3]);
                const float r = fast_rsqrt(wave_sum(s) * (1.0f / DM) + EPS);
                if (mr < SEQ) {
                    unsigned long long* o8 = (unsigned long long*)(XN + (size_t)mr * DM) + lane;
#pragma unroll
                    for (int j = 0; j < 4; ++j) { const f32x4 y = v[rr][j] * r * gv[j]; o8[64 * j] = (unsigned long long)cvtpk(y[0], y[1]) | ((unsigned long long)cvtpk(y[2], y[3]) << 32); }
                }
            }
        }
    }
    GRID_BAR();

    {
        pg8::Gemm g{XN, Win_t, SEQ, NIN, DM}; pg8::TailSplitOrder S; S.init(SEQ, NIN, G, bx);
        EpiInProj E{proj, a.in[3], a.in[4], 0.125f * LOG2E};
        pg8::gemm_phase<false, true>(lds, g, S, E);
        const int rem = (2 * S.rem > G) ? S.rem : 2 * S.rem;
        if (rem == 0) convert_w_out_up(a, Wout_t, Wup_t, scr, bx * 8 + wave, G * 8, lane);
        else if (bx >= rem) convert_w_out_up(a, Wout_t, Wup_t, scr, (bx - rem) * 8 + wave, (G - rem) * 8, lane);
    }
    GRID_BAR();

    {
        constexpr int NU = SEQ / 64, NPER = NU / 8;
        const bool xa = (G & 7) == 0;
        const int base = xa ? (bx & 7) * NPER : 0, j0 = xa ? (bx >> 3) : bx, js = xa ? (G >> 3) : G, jn = xa ? NPER : NU;
        for (int j = j0; j < jn; j += js) p2_unit(lds, proj, mix, a.in[5], a.in[7], a.in[6], a.in[8], base + j, tid, lane, wave);
    }
    GRID_BAR();

    {
        pg8::Gemm g{mix, Wout_t, SEQ, DM, DM}; pg8::StaticOrder S; S.init(SEQ, DM, G, bx);
        EpiOutProj E{x, XN, part};
        pg8::gemm_phase(lds, g, S, E);
    }
    GRID_BAR();

    {
        pg8::Gemm g{XN, Wup_t, SEQ, NUP, DM}; pg8::StaticOrder S; S.init(SEQ, NUP, G, bx);
        EpiUpConv E{act, part, a.in[12], edge, lds + XCH_OFF, -1};
        pg8::gemm_phase<true, false>(lds, g, S, E);
        const int rem = S.nwg % G;
        if (rem == 0) convert_w_down(a, Wdn_t, scr, bx * 8 + wave, G * 8, lane);
        else if (bx >= rem) convert_w_down(a, Wdn_t, scr, (bx - rem) * 8 + wave, (G - rem) * 8, lane);
    }
    GRID_BAR();

    {
        pg8::Gemm g{act, Wdn_t, SEQ, DM, DFF}; pg8::StaticOrder S; S.init(SEQ, DM, G, bx);
        const float* cw = a.in[12];
        constexpr int NCG = DFF / 8;
        pg8::TailSplitOrder S4; S4.init(SEQ, NUP, G, bx);
        const bool split4 = false;
        pg8::Unit fu;
        for (int i = 0; S.next(i, fu); ++i) {
            const int pm = fu.pm;
            for (int id = tid; id < 2 * NCG; id += 512) {
                const int rs = id / NCG, f0 = 8 * (id - rs * NCG);
                const float* et = edge + (size_t)(pm * 8 + rs) * NUP;
                const float* e1 = rs == 0 ? (pm > 0 ? edge + (size_t)((pm - 1) * 8 + 3) * NUP : nullptr) : edge + (size_t)(pm * 8 + 0) * NUP;
                const float* e2 = pm > 0 ? edge + (size_t)((pm - 1) * 8 + (rs == 0 ? 2 : 3)) * NUP : nullptr;
                fix_rows(act + (size_t)(pm * 256 + rs) * DFF + f0, cw, et, e1, e2, f0);
            }
            if (split4) {
                for (int pn4 = 0; pn4 < S4.b.nN; ++pn4) {
                    const int L = S4.b.index_of(pm, pn4);
                    if (L < S4.full * G) continue;
                    if (tid < 32) {
                        const int rs = tid >> 4, f0 = 128 * pn4 + 8 * (tid & 15);
                        const float* et = edge + (size_t)(pm * 8 + 6 + rs) * NUP;
                        const float* e1 = edge + (size_t)(pm * 8 + (rs == 0 ? 5 : 6)) * NUP;
                        const float* e2 = edge + (size_t)(pm * 8 + (rs == 0 ? 4 : 5)) * NUP;
                        fix_rows(act + (size_t)(pm * 256 + 128 + rs) * DFF + f0, cw, et, e1, e2, f0);
                    }
                }
            }
        }
        asm volatile("s_waitcnt vmcnt(0)" ::: "memory");
        __syncthreads();
        EpiDown E{XN, out};
        pg8::gemm_phase(lds, g, S, E);
    }
}

extern "C" void kernel_launch(void* const* d_in, const int* in_sizes, int n_in, void* d_out, int out_size, void* d_ws, size_t ws_size, hipStream_t stream) {
    static int grid_blocks = 0;
    if (grid_blocks == 0) {
        if (n_in != 14 || in_sizes[0] != SEQ * DM || out_size != SEQ * DM || ws_size < WS_END) { fprintf(stderr, "kernel_launch: unexpected shapes (n_in %d, ws %zu)\n", n_in, ws_size); grid_blocks = -1; return; }
        int dev = 0, cus = 0, per_cu = 0;
        hipGetDevice(&dev);
        hipDeviceGetAttribute(&cus, hipDeviceAttributeMultiprocessorCount, dev);
        if (hipFuncSetAttribute((const void*)fwd_megakernel, hipFuncAttributeMaxDynamicSharedMemorySize, LDS_BYTES) != hipSuccess) { fprintf(stderr, "kernel_launch: hipFuncSetAttribute failed\n"); grid_blocks = -1; return; }
        hipOccupancyMaxActiveBlocksPerMultiprocessor(&per_cu, (const void*)fwd_megakernel, 512, LDS_BYTES);
        if (per_cu < 1) per_cu = 1;
        grid_blocks = cus * 1;
        (void)per_cu; (void)hipGetLastError();
    }
    if (grid_blocks < 0) return;
    Args a{};
    for (int i = 0; i < 14; ++i) a.in[i] = (const float*)d_in[i];
    a.out = (float*)d_out; a.ws = (unsigned char*)d_ws;
    if (hipMemsetAsync((char*)d_ws + WS_CTL, 0, CTL_ZERO_BYTES, stream) != hipSuccess) { fprintf(stderr, "kernel_launch: memset failed\n"); return; }
    void* args[] = {&a};
    hipError_t e = hipLaunchCooperativeKernel((const void*)fwd_megakernel, dim3(grid_blocks), dim3(512), args, LDS_BYTES, stream);
    if (e != hipSuccess) fprintf(stderr, "cooperative launch failed: %s (grid %d)\n", hipGetErrorString(e), grid_blocks);
}
```
